# Optimizing an MI355X kernel written in HIP

```python
import jax, jax.numpy as jnp
from jax import lax
import numpy as np

D_MODEL = 1024
BATCH = 1
SEQ = 16384
DEPTH = 2

GRID_W = 64
CTX_LEN = 256
N_MIXERS = 2
GLA_HEADS = 4
GLA_DK = D_MODEL // 2
GLA_DV = D_MODEL
GLA_HEAD_K = GLA_DK // GLA_HEADS
GLA_HEAD_V = GLA_DV // GLA_HEADS
GLA_GATE_RANK = 16
GLA_TAU = 16.0
GLA_CHUNK = 64
LRU_WIDTH = D_MODEL
LRU_BLOCKS = 4
LRU_BLOCK = LRU_WIDTH // LRU_BLOCKS
LRU_C = 8.0
CONV_W = 4
CONV_LEFT = 2
FFN_HIDDEN = -(-8 * D_MODEL // (3 * 256)) * 256
EPS = 1e-6

kernel_name = "hybrid_gla_rglru_prefix_dit"


def rmsnorm(x, g):
    xf = x.astype(jnp.float32)
    y = xf * lax.rsqrt(jnp.mean(xf * xf, axis=-1, keepdims=True) + EPS)
    return (y * g.astype(jnp.float32)).astype(x.dtype)


def swiglu(h, w1, w3, w2):
    return (jax.nn.silu(h @ w1) * (h @ w3)) @ w2


def _heads(t, n):
    B, L, F = t.shape
    return t.reshape(B, L, n, F // n).transpose(0, 2, 1, 3)


def _flip_if(t, rev, axis):
    return jnp.flip(t, axis=axis) if rev else t


def gla_chunked(q, k, v, log_a, s0):
    B, H, L, dk = q.shape
    dv = v.shape[-1]
    C = GLA_CHUNK
    N = L // C
    q = q.reshape(B, H, N, C, dk)
    k = k.reshape(B, H, N, C, dk)
    v = v.reshape(B, H, N, C, dv)
    b = jnp.cumsum(log_a.reshape(B, H, N, C, dk), axis=3)
    b_last = b[:, :, :, -1:, :]
    q_dec = q * jnp.exp(b)
    k_inv = k * jnp.exp(-b)
    k_to_end = k * jnp.exp(b_last - b)
    mask = jnp.tril(jnp.ones((C, C), dtype=bool))
    att = jnp.where(mask, jnp.einsum('bhnik,bhnjk->bhnij', q_dec, k_inv), 0.0)
    o_intra = jnp.einsum('bhnij,bhnjv->bhniv', att, v)
    u = jnp.einsum('bhnck,bhncv->bhnkv', k_to_end, v)
    decay = jnp.exp(b_last[:, :, :, 0, :])

    def step(s, inp):
        d, uu = inp
        return d[..., None] * s + uu, s

    s_final, s_prev = lax.scan(step, s0, (jnp.moveaxis(decay, 2, 0), jnp.moveaxis(u, 2, 0)))
    s_prev = jnp.moveaxis(s_prev, 0, 2)
    o_inter = jnp.einsum('bhnck,bhnkv->bhncv', q_dec, s_prev)
    return (o_intra + o_inter).reshape(B, H, L, dv), s_final


def gla_mixer(h_c, h_l, w_in, gw1, gw2, gb, hn_g, w_out, need_ctx):
    f32 = jnp.float32
    B = h_l.shape[0]

    def project(h):
        z = h @ w_in
        q, k, v, g = jnp.split(z, [GLA_DK, 2 * GLA_DK, 2 * GLA_DK + GLA_DV], axis=-1)
        q = _heads(q, GLA_HEADS).astype(f32) * (GLA_HEAD_K ** -0.5)
        return q, _heads(k, GLA_HEADS).astype(f32), _heads(v, GLA_HEADS).astype(f32), g

    def log_gate(h, d):
        z = (h @ gw1[d]) @ gw2[d] + gb[d]
        return _heads(jax.nn.log_sigmoid(z.astype(f32)) / GLA_TAU, GLA_HEADS)

    qc, kc, vc, gc = project(h_c)
    ql, kl, vl, gl = project(h_l)
    s0 = jnp.zeros((B, GLA_HEADS, GLA_HEAD_K, GLA_HEAD_V), f32)
    outs_c, outs_l = [], []
    for d in range(2):
        rev = d == 1
        oc, s_ctx = gla_chunked(_flip_if(qc, rev, 2), _flip_if(kc, rev, 2), _flip_if(vc, rev, 2),
                                _flip_if(log_gate(h_c, d), rev, 2), s0)
        ol, _ = gla_chunked(_flip_if(ql, rev, 2), _flip_if(kl, rev, 2), _flip_if(vl, rev, 2),
                            _flip_if(log_gate(h_l, d), rev, 2), s_ctx)
        outs_c.append(_flip_if(oc, rev, 2))
        outs_l.append(_flip_if(ol, rev, 2))

    def finish(o, g, h):
        Bh, H, L, dv = o.shape
        o = rmsnorm(o, hn_g).transpose(0, 2, 1, 3).reshape(Bh, L, H * dv)
        return ((o * jax.nn.silu(g.astype(f32))) @ w_out).astype(h.dtype)

    y_l = finish(outs_l[0] + outs_l[1], gl, h_l)
    y_c = finish(outs_c[0] + outs_c[1], gc, h_c) if need_ctx else None
    return y_c, y_l


def conv_centred(u, w, b):
    L = u.shape[1]
    up = jnp.pad(u, ((0, 0), (CONV_LEFT, CONV_W - 1 - CONV_LEFT), (0, 0)))
    y = b
    for j in range(CONV_W):
        y = y + up[:, j:j + L, :] * w[j]
    return y


def rglru_coeffs(u, wa, ba, wx, bx, lam):
    B, L, W = u.shape
    ub = u.reshape(B, L, LRU_BLOCKS, LRU_BLOCK)
    r = jax.nn.sigmoid(jnp.einsum('blgi,gij->blgj', ub, wa).reshape(B, L, W) + ba)
    i = jax.nn.sigmoid(jnp.einsum('blgi,gij->blgj', ub, wx).reshape(B, L, W) + bx)
    log_a = -LRU_C * r * jax.nn.softplus(-lam.astype(jnp.float32))
    a = jnp.exp(log_a)
    return a, jnp.sqrt(-jnp.expm1(2.0 * log_a)) * (i * u)


def linear_scan(a, b, h0):
    b = b.at[:, 0].add(a[:, 0] * h0)

    def comb(left, right):
        a1, b1 = left
        a2, b2 = right
        return a1 * a2, a2 * b1 + b2

    _, h = lax.associative_scan(comb, (a, b), axis=1)
    return h


def rglru_mixer(h_c, h_l, w_in, conv_w, conv_b, ga_w, ga_b, gx_w, gx_b, lam, w_out, need_ctx):
    f32 = jnp.float32
    B = h_l.shape[0]

    def branches(h):
        z = h @ w_in
        y, u = jnp.split(z, 2, axis=-1)
        return jax.nn.gelu(y.astype(f32)), conv_centred(u, conv_w, conv_b).astype(f32)

    yc, uc = branches(h_c)
    yl, ul = branches(h_l)
    h0 = jnp.zeros((B, LRU_WIDTH), f32)
    hs_c, hs_l = [], []
    for d in range(2):
        rev = d == 1
        a, b = rglru_coeffs(_flip_if(uc, rev, 1), ga_w[d], ga_b[d], gx_w[d], gx_b[d], lam[d])
        hc = linear_scan(a, b, h0)
        a, b = rglru_coeffs(_flip_if(ul, rev, 1), ga_w[d], ga_b[d], gx_w[d], gx_b[d], lam[d])
        hl = linear_scan(a, b, hc[:, -1])
        hs_c.append(_flip_if(hc, rev, 1))
        hs_l.append(_flip_if(hl, rev, 1))
    y_l = (((hs_l[0] + hs_l[1]) * yl) @ w_out).astype(h_l.dtype)
    y_c = (((hs_c[0] + hs_c[1]) * yc) @ w_out).astype(h_c.dtype) if need_ctx else None
    return y_c, y_l


def setup_inputs(seed: int = 0) -> dict:
    key = jax.random.key(seed)
    ks = list(jax.random.split(key, 32))
    n_gla = (DEPTH + 1) // 2
    n_lru = DEPTH // 2
    D = D_MODEL
    nrm = lambda k, shape, s: jax.random.normal(k, shape, jnp.float32) * s
    u_a = jax.random.uniform(ks[21], (n_lru, 2, LRU_WIDTH), jnp.float32, 0.9, 0.999)
    s_root = u_a ** (1.0 / LRU_C)
    return {
        'x': nrm(ks[0], (BATCH, SEQ, D), 1.0),
        'c': nrm(ks[1], (BATCH, D), 1.0),
        'ctx': nrm(ks[2], (BATCH, CTX_LEN, D), 1.0),
        'c_ctx': nrm(ks[3], (D,), 1.0),
        'norm_mix_g': 1.0 + nrm(ks[4], (DEPTH, D), 0.1),
        'norm_ffn_g': 1.0 + nrm(ks[5], (DEPTH, D), 0.1),
        'w_mod': nrm(ks[6], (DEPTH, D, 6 * D), D ** -0.5),
        'b_mod': nrm(ks[7], (DEPTH, 6 * D), 0.02),
        'gla_w_in': nrm(ks[8], (n_gla, D, 2 * GLA_DK + 2 * GLA_DV), D ** -0.5),
        'gla_gate_w1': nrm(ks[9], (n_gla, 2, D, GLA_GATE_RANK), D ** -0.5),
        'gla_gate_w2': nrm(ks[10], (n_gla, 2, GLA_GATE_RANK, GLA_DK), GLA_GATE_RANK ** -0.5),
        'gla_gate_b': nrm(ks[11], (n_gla, 2, GLA_DK), 0.5),
        'gla_head_norm_g': 1.0 + nrm(ks[12], (n_gla, GLA_HEAD_V), 0.1),
        'gla_w_out': nrm(ks[13], (n_gla, GLA_DV, D), GLA_DV ** -0.5),
        'lru_w_in': nrm(ks[14], (n_lru, D, 2 * LRU_WIDTH), D ** -0.5),
        'lru_conv_w': nrm(ks[15], (n_lru, CONV_W, LRU_WIDTH), CONV_W ** -0.5),
        'lru_conv_b': nrm(ks[16], (n_lru, LRU_WIDTH), 0.02),
        'lru_gate_a_w': nrm(ks[17], (n_lru, 2, LRU_BLOCKS, LRU_BLOCK, LRU_BLOCK), LRU_BLOCK ** -0.5),
        'lru_gate_a_b': nrm(ks[18], (n_lru, 2, LRU_WIDTH), 0.1),
        'lru_gate_x_w': nrm(ks[19], (n_lru, 2, LRU_BLOCKS, LRU_BLOCK, LRU_BLOCK), LRU_BLOCK ** -0.5),
        'lru_gate_x_b': nrm(ks[20], (n_lru, 2, LRU_WIDTH), 0.1),
        'lru_lambda': jnp.log(s_root) - jnp.log1p(-s_root),
        'lru_w_out': nrm(ks[22], (n_lru, LRU_WIDTH, D), LRU_WIDTH ** -0.5),
        'ffn_w1': nrm(ks[23], (DEPTH, D, FFN_HIDDEN), D ** -0.5),
        'ffn_w3': nrm(ks[24], (DEPTH, D, FFN_HIDDEN), D ** -0.5),
        'ffn_w2': nrm(ks[25], (DEPTH, FFN_HIDDEN, D), FFN_HIDDEN ** -0.5),
        'final_norm_g': 1.0 + nrm(ks[26], (D,), 0.1),
    }


def reference(x, c, ctx, c_ctx, norm_mix_g, norm_ffn_g, w_mod, b_mod,
              gla_w_in, gla_gate_w1, gla_gate_w2, gla_gate_b, gla_head_norm_g, gla_w_out,
              lru_w_in, lru_conv_w, lru_conv_b, lru_gate_a_w, lru_gate_a_b, lru_gate_x_w,
              lru_gate_x_b, lru_lambda, lru_w_out, ffn_w1, ffn_w3, ffn_w2, final_norm_g):
    B, S, D = x.shape
    rows = S // GRID_W

    def to_col(t):
        return t.reshape(B, rows, GRID_W, D).transpose(0, 2, 1, 3).reshape(B, S, D)

    def from_col(t):
        return t.reshape(B, GRID_W, rows, D).transpose(0, 2, 1, 3).reshape(B, S, D)

    h_ctx = ctx
    for i in range(DEPTH):
        last = i == DEPTH - 1
        j = i // N_MIXERS
        m_l = (jax.nn.silu(c) @ w_mod[i] + b_mod[i])[:, None, :]
        m_c = (jax.nn.silu(c_ctx) @ w_mod[i] + b_mod[i])[None, None, :]
        sh1, sc1, g1, sh2, sc2, g2 = jnp.split(m_l, 6, axis=-1)
        csh1, csc1, cg1, csh2, csc2, cg2 = jnp.split(m_c, 6, axis=-1)
        a_l = rmsnorm(x, norm_mix_g[i]) * (1.0 + sc1) + sh1
        a_c = rmsnorm(h_ctx, norm_mix_g[i]) * (1.0 + csc1) + csh1
        if i % N_MIXERS == 0:
            y_c, y_l = gla_mixer(a_c, a_l, gla_w_in[j], gla_gate_w1[j], gla_gate_w2[j], gla_gate_b[j],
                                 gla_head_norm_g[j], gla_w_out[j], not last)
        else:
            y_c, y_lc = rglru_mixer(a_c, to_col(a_l), lru_w_in[j], lru_conv_w[j], lru_conv_b[j],
                                    lru_gate_a_w[j], lru_gate_a_b[j], lru_gate_x_w[j], lru_gate_x_b[j],
                                    lru_lambda[j], lru_w_out[j], not last)
            y_l = from_col(y_lc)
        x = x + g1 * y_l
        f_l = rmsnorm(x, norm_ffn_g[i]) * (1.0 + sc2) + sh2
        x = x + g2 * swiglu(f_l, ffn_w1[i], ffn_w3[i], ffn_w2[i])
        if not last:
            h_ctx = h_ctx + cg1 * y_c
            f_c = rmsnorm(h_ctx, norm_ffn_g[i]) * (1.0 + csc2) + csh2
            h_ctx = h_ctx + cg2 * swiglu(f_c, ffn_w1[i], ffn_w3[i], ffn_w2[i])
    return rmsnorm(x, final_norm_g)
```

```cpp
#include <hip/hip_runtime.h>
#include <hip/hip_cooperative_groups.h>
#include <stdint.h>
#include <stdio.h>
namespace cg = cooperative_groups;

#ifndef MEGA
#define MEGA 1
#endif
#ifndef XSYNC
#define XSYNC 0
#endif
#ifndef REPN
#define REPN 1
#endif
#ifndef REPMASK
#define REPMASK 0u
#endif
#ifndef RSEQ_AFTER
#define RSEQ_AFTER -1
#endif
#ifndef RSEQ_FROM
#define RSEQ_FROM 0
#endif
#ifndef ONLY
#define ONLY -1
#endif
#ifndef PMASK
#define PMASK 0xFFFFFFFFu
#endif
#define PHEN(n) (((ONLY) < 0 || (ONLY) == (n)) && ((PMASK >> (n)) & 1u))

typedef unsigned short u16;
typedef __attribute__((ext_vector_type(8))) short bf16x8;
typedef __attribute__((ext_vector_type(4))) float f32x4;

constexpr int MR = 16640;
constexpr int HID = 2816;
constexpr int LDT = 72;
constexpr int LDK = 136;
constexpr int DYN_LDS = 131072;
constexpr int NTHR = 512;
constexpr int NPHASE = 21;

constexpr size_t OFF_WGIN = 0;
constexpr size_t OFF_WGOUT = OFF_WGIN + (size_t)3328 * 1024 * 2;
constexpr size_t OFF_WLIN = OFF_WGOUT + (size_t)1024 * 1024 * 2;
constexpr size_t OFF_WGATE = OFF_WLIN + (size_t)2048 * 1024 * 2;
constexpr size_t OFF_WLOUT = OFF_WGATE + (size_t)2 * 2048 * 256 * 2;
constexpr size_t OFF_W13 = OFF_WLOUT + (size_t)1024 * 1024 * 2;
constexpr size_t OFF_W2 = OFF_W13 + (size_t)2 * 5632 * 1024 * 2;
constexpr size_t OFF_MOD = OFF_W2 + (size_t)2 * 1024 * 2816 * 2;
constexpr size_t OFF_BAR = OFF_MOD + (size_t)2 * 2 * 6144 * 4;
constexpr size_t OFF_HCTX = OFF_BAR + 16384;
constexpr size_t OFF_ABUF = OFF_HCTX + (size_t)256 * 1024 * 4;
constexpr size_t OFF_REG = OFF_ABUF + (size_t)MR * 1024 * 2;
constexpr size_t SZ_QK = (size_t)MR * 512 * 2;
constexpr size_t OFF_Q0 = OFF_REG;
constexpr size_t OFF_K0 = OFF_Q0 + SZ_QK;
constexpr size_t OFF_Q1 = OFF_K0 + SZ_QK;
constexpr size_t OFF_K1 = OFF_Q1 + SZ_QK;
constexpr size_t OFF_VT = OFF_K1 + SZ_QK;
constexpr size_t OFF_G = OFF_VT + (size_t)1024 * MR * 2;
constexpr size_t OFF_R = OFF_G + (size_t)MR * 1024 * 2;
constexpr size_t OFF_UT = OFF_R + (size_t)MR * 32 * 4;
constexpr size_t OFF_DEC = OFF_UT + (size_t)2 * 65 * 4 * 32768 * 2;
constexpr size_t END_GLA = OFF_DEC + (size_t)2 * 65 * 4 * 128 * 4;
constexpr size_t OFF_HID = OFF_REG;
constexpr size_t OFF_Y = OFF_REG;
constexpr size_t OFF_LA = OFF_Y + (size_t)MR * 1024 * 2;
constexpr size_t OFF_BB = OFF_LA + (size_t)2 * MR * 1024 * 2;
constexpr size_t OFF_U = OFF_LA;
constexpr size_t OFF_AGG = OFF_BB + (size_t)2 * MR * 1024 * 2;
constexpr int NSEG = 136;
constexpr size_t END_LRU = OFF_AGG + (size_t)2 * 2 * NSEG * 1024 * 4;
static_assert(END_GLA <= 268435456ull, "ws");
static_assert(END_LRU <= 268435456ull, "ws");
static_assert(OFF_HID + (size_t)MR * HID * 2 <= 268435456ull, "ws");

struct Params {
  const float* in[27];
  float* out;
  char* ws;
};

typedef __attribute__((ext_vector_type(2))) __bf16 bf16v2;
typedef __attribute__((ext_vector_type(2))) float f32v2;
__device__ __forceinline__ u16 f2bf(float f) { return __builtin_bit_cast(u16, (__bf16)f); }
__device__ __forceinline__ float bf2f(u16 h) { return __uint_as_float(((unsigned)h) << 16); }
__device__ __forceinline__ unsigned pack2(float a, float b) {
  f32v2 v = {a, b};
  return __builtin_bit_cast(unsigned, __builtin_convertvector(v, bf16v2));
}
__device__ __forceinline__ float sigmoid_f(float x) { return __frcp_rn(1.f + __expf(-x)); }
__device__ __forceinline__ float silu_f(float x) { return x * sigmoid_f(x); }
__device__ __forceinline__ float softplus_f(float x) { return fmaxf(x, 0.f) + log1pf(__expf(-fabsf(x))); }
__device__ __forceinline__ float gelu_tanh(float x) {
  float u = 0.7978845608028654f * (x + 0.044715f * x * x * x);
  float th = 1.f - 2.f * __frcp_rn(1.f + __expf(2.f * u));
  return 0.5f * x * (1.f + th);
}
__device__ __forceinline__ f32x4 mfma16(bf16x8 a, bf16x8 b, f32x4 c) {
  return __builtin_amdgcn_mfma_f32_16x16x32_bf16(a, b, c, 0, 0, 0);
}
__device__ __forceinline__ bf16x8 lds_frag(const u16* s, int off) {
  return *reinterpret_cast<const bf16x8*>(s + off);
}

__device__ __forceinline__ int opaque_tid() { int t = threadIdx.x; asm volatile("" : "+v"(t)); return t; }

struct TJob {
  const float* src; int src_ld; int K; int N; u16* dst; int dst_ld; int map; int which; int nbase; float scale; int scale_n;
};
__device__ __forceinline__ TJob get_job(const Params& p, int j) {
  TJob t; t.map = 0; t.which = 0; t.nbase = 0; t.scale = 1.f; t.scale_n = 0;
  char* ws = p.ws;
  if (j == 0) { t.src = p.in[8]; t.src_ld = 3072; t.K = 1024; t.N = 3072; t.dst = (u16*)(ws + OFF_WGIN); t.dst_ld = 1024; t.scale = 0.08838834764831845f; t.scale_n = 512; }
  else if (j <= 2) { int d = j - 1; t.src = p.in[9] + d * 1024 * 16; t.src_ld = 16; t.K = 1024; t.N = 16; t.dst = (u16*)(ws + OFF_WGIN); t.dst_ld = 1024; t.nbase = 3072 + d * 16; }
  else if (j == 3) { t.src = p.in[13]; t.src_ld = 1024; t.K = 1024; t.N = 1024; t.dst = (u16*)(ws + OFF_WGOUT); t.dst_ld = 1024; }
  else if (j == 4) { t.src = p.in[14]; t.src_ld = 2048; t.K = 1024; t.N = 2048; t.dst = (u16*)(ws + OFF_WLIN); t.dst_ld = 1024; }
  else if (j <= 20) { int q = j - 5; int d = q >> 3, g = (q >> 1) & 3, gate = q & 1;
    t.src = (gate ? p.in[19] : p.in[17]) + (size_t)(d * 4 + g) * 65536; t.src_ld = 256; t.K = 256; t.N = 256;
    t.dst = (u16*)(ws + OFF_WGATE) + (size_t)d * 2048 * 256; t.dst_ld = 256; t.map = 1; t.which = gate; t.nbase = g * 512; }
  else if (j == 21) { t.src = p.in[22]; t.src_ld = 1024; t.K = 1024; t.N = 1024; t.dst = (u16*)(ws + OFF_WLOUT); t.dst_ld = 1024; }
  else if (j <= 25) { int q = j - 22; int l = q >> 1, which = q & 1;
    t.src = (which ? p.in[24] : p.in[23]) + (size_t)l * 1024 * 2816; t.src_ld = 2816; t.K = 1024; t.N = 2816;
    t.dst = (u16*)(ws + OFF_W13) + (size_t)l * 5632 * 1024; t.dst_ld = 1024; t.map = 1; t.which = which; }
  else { int l = j - 26; t.src = p.in[25] + (size_t)l * 2816 * 1024; t.src_ld = 1024; t.K = 2816; t.N = 1024;
    t.dst = (u16*)(ws + OFF_W2) + (size_t)l * 1024 * 2816; t.dst_ld = 2816; }
  return t;
}
__device__ __forceinline__ void prep_tile(const TJob& t, int tl, bool act, float* tile, int tid) {
  const int nkt = t.K >> 6;
  const int tlc = act ? tl : 0;
  const int k0 = (tlc % nkt) * 64, n0 = (tlc / nkt) * 64;
  {
    const int nn = tid & 63, kb = tid >> 6;
    const bool ok = act && (n0 + nn) < t.N;
    const float sc = ((n0 + nn) < t.scale_n) ? t.scale : 1.f;
#pragma unroll
    for (int i = 0; i < 16; ++i) {
      int kk = kb + i * 4;
      float v = ok ? t.src[(size_t)(k0 + kk) * t.src_ld + n0 + nn] * sc : 0.f;
      tile[kk * 65 + nn] = v;
    }
  }
  __syncthreads();
  {
    const int kk = tid & 63, nb = tid >> 6;
#pragma unroll
    for (int i = 0; i < 16; ++i) {
      int nn = nb + i * 4; int n = n0 + nn;
      if (act && n < t.N) {
        int drow = t.map ? (t.nbase + (n >> 4) * 32 + t.which * 16 + (n & 15)) : (t.nbase + n);
        t.dst[(size_t)drow * t.dst_ld + k0 + kk] = f2bf(tile[kk * 65 + nn]);
      }
    }
  }
  __syncthreads();
}
__device__ __forceinline__ bool job_is_early(int j) { return j <= 3 || j == 22 || j == 23; }
constexpr int NDEFER_TILES = 3840;

constexpr int NJOBS = 28;
constexpr int NMODITEMS = 192;

__device__ __forceinline__ void phase_prep(const Params& p, char* smem) {
  const int tid0 = opaque_tid(); const int tid = tid0 & 255;
  const int vhalf = __builtin_amdgcn_readfirstlane(tid0 >> 8);
  smem += vhalf * 65536;
  float* tile = (float*)smem;
  const int vb = blockIdx.x * 2 + vhalf, nvb = gridDim.x * 2;
  if (vb < NMODITEMS) {
    const int mi = vb; const int l = mi / 96, ng = mi % 96;
    const int cq = tid & 15, kq = tid >> 4;
    const float* wm = p.in[6] + (size_t)l * 1024 * 6144 + ng * 64 + cq * 4;
    float al[4] = {0, 0, 0, 0}, ac[4] = {0, 0, 0, 0};
#pragma unroll 8
    for (int k = kq; k < 1024; k += 16) {
      float4 w = *reinterpret_cast<const float4*>(wm + (size_t)k * 6144);
      float sl = silu_f(p.in[1][k]), sc = silu_f(p.in[3][k]);
      al[0] += sl * w.x; al[1] += sl * w.y; al[2] += sl * w.z; al[3] += sl * w.w;
      ac[0] += sc * w.x; ac[1] += sc * w.y; ac[2] += sc * w.z; ac[3] += sc * w.w;
    }
    float* red = (float*)smem;
#pragma unroll
    for (int e = 0; e < 4; ++e) { red[(0 * 16 + kq) * 64 + cq * 4 + e] = al[e]; red[(1 * 16 + kq) * 64 + cq * 4 + e] = ac[e]; }
  }
  __syncthreads();
  if (vb < NMODITEMS && tid < 128) {
    const int mi = vb; const int l = mi / 96, ng = mi % 96;
    float* red = (float*)smem;
    int sidx = tid >> 6, col = tid & 63; float sum = 0.f;
#pragma unroll
    for (int q = 0; q < 16; ++q) sum += red[(sidx * 16 + q) * 64 + col];
    int n = ng * 64 + col;
    float* mod = (float*)(p.ws + OFF_MOD);
    mod[(l * 2 + sidx) * 6144 + n] = sum + p.in[7][l * 6144 + n];
  }
  if (vb == nvb - 1) {
    u16* w = (u16*)(p.ws + OFF_WGIN) + (size_t)3104 * 1024;
    for (int i = tid; i < 224 * 1024 / 8; i += 256) reinterpret_cast<uint4*>(w)[i] = make_uint4(0, 0, 0, 0);
  }
  __syncthreads();
  int offset = 0;
  for (int j = 0; j < NJOBS; ++j) {
    if (!job_is_early(j)) continue;
    const TJob t = get_job(p, j);
    const int nkt = t.K >> 6;
    const int ntile = nkt * ((t.N + 63) >> 6);
    const int first0 = (((blockIdx.x * 2) - offset) % nvb + nvb) % nvb;
    const int first1 = (((blockIdx.x * 2 + 1) - offset) % nvb + nvb) % nvb;
    const int fmin = min(first0, first1);
    const int first = vhalf ? first1 : first0;
    for (int base = 0; fmin + base < ntile; base += nvb) {
      const int tl = first + base;
      prep_tile(t, tl, tl < ntile, tile, tid);
    }
    offset = (offset + ntile) % nvb;
  }
}

__device__ __forceinline__ void phase_normmod(const Params& p, const float* src_ctx, const float* src_lat, const float* gvec,
                              const float* modl, int sh_off, int sc_off, int perm, float* hctx_init) {
  const int tid_ = opaque_tid(); const int lane = tid_ & 63, wave = tid_ >> 6;
  u16* abuf = (u16*)(p.ws + OFF_ABUF);
  const int gw = blockIdx.x * 8 + wave, nw = gridDim.x * 8;
  for (int dr = gw; dr < 256; dr += nw) {
    const float* src = src_ctx + (size_t)dr * 1024; const float* mods = modl + 6144;
    float4 v[4]; float ss = 0.f;
#pragma unroll
    for (int i = 0; i < 4; ++i) { v[i] = *reinterpret_cast<const float4*>(src + i * 256 + lane * 4); ss += v[i].x * v[i].x + v[i].y * v[i].y + v[i].z * v[i].z + v[i].w * v[i].w; }
    if (hctx_init) {
#pragma unroll
      for (int i = 0; i < 4; ++i) *reinterpret_cast<float4*>(hctx_init + (size_t)dr * 1024 + i * 256 + lane * 4) = v[i];
    }
#pragma unroll
    for (int o = 32; o >= 1; o >>= 1) ss += __shfl_xor(ss, o);
    const float rstd = rsqrtf(ss * (1.f / 1024.f) + 1e-6f);
#pragma unroll
    for (int i = 0; i < 4; ++i) {
      int col = i * 256 + lane * 4;
      float4 g = *reinterpret_cast<const float4*>(gvec + col);
      float4 sc = *reinterpret_cast<const float4*>(mods + sc_off + col);
      float4 sh = *reinterpret_cast<const float4*>(mods + sh_off + col);
      uint2 o2;
      o2.x = pack2(v[i].x * rstd * g.x * (1.f + sc.x) + sh.x, v[i].y * rstd * g.y * (1.f + sc.y) + sh.y);
      o2.y = pack2(v[i].z * rstd * g.z * (1.f + sc.z) + sh.z, v[i].w * rstd * g.w * (1.f + sc.w) + sh.w);
      *reinterpret_cast<uint2*>(abuf + (size_t)dr * 1024 + col) = o2;
    }
  }
  float4 gs[4], shv[4];
#pragma unroll
  for (int i = 0; i < 4; ++i) {
    int col = i * 256 + lane * 4;
    float4 g = *reinterpret_cast<const float4*>(gvec + col);
    float4 sc = *reinterpret_cast<const float4*>(modl + sc_off + col);
    shv[i] = *reinterpret_cast<const float4*>(modl + sh_off + col);
    gs[i].x = g.x * (1.f + sc.x); gs[i].y = g.y * (1.f + sc.y); gs[i].z = g.z * (1.f + sc.z); gs[i].w = g.w * (1.f + sc.w);
  }
  for (int t0 = gw; t0 < 16384; t0 += 2 * nw) {
    const int t1 = t0 + nw;
    const bool has1 = t1 < 16384;
    const int t1c = has1 ? t1 : t0;
    const int lr0 = perm ? ((t0 & 255) * 64 + (t0 >> 8)) : t0;
    const int lr1 = perm ? ((t1c & 255) * 64 + (t1c >> 8)) : t1c;
    const float* s0 = src_lat + (size_t)lr0 * 1024; const float* s1 = src_lat + (size_t)lr1 * 1024;
    float4 v0[4], v1[4]; float ss0 = 0.f, ss1 = 0.f;
#pragma unroll
    for (int i = 0; i < 4; ++i) { v0[i] = *reinterpret_cast<const float4*>(s0 + i * 256 + lane * 4); v1[i] = *reinterpret_cast<const float4*>(s1 + i * 256 + lane * 4); }
#pragma unroll
    for (int i = 0; i < 4; ++i) {
      ss0 += v0[i].x * v0[i].x + v0[i].y * v0[i].y + v0[i].z * v0[i].z + v0[i].w * v0[i].w;
      ss1 += v1[i].x * v1[i].x + v1[i].y * v1[i].y + v1[i].z * v1[i].z + v1[i].w * v1[i].w;
    }
#pragma unroll
    for (int o = 32; o >= 1; o >>= 1) { ss0 += __shfl_xor(ss0, o); ss1 += __shfl_xor(ss1, o); }
    const float r0 = rsqrtf(ss0 * (1.f / 1024.f) + 1e-6f), r1 = rsqrtf(ss1 * (1.f / 1024.f) + 1e-6f);
#pragma unroll
    for (int i = 0; i < 4; ++i) {
      int col = i * 256 + lane * 4;
      uint2 o2;
      o2.x = pack2(v0[i].x * r0 * gs[i].x + shv[i].x, v0[i].y * r0 * gs[i].y + shv[i].y);
      o2.y = pack2(v0[i].z * r0 * gs[i].z + shv[i].z, v0[i].w * r0 * gs[i].w + shv[i].w);
      *reinterpret_cast<uint2*>(abuf + (size_t)(256 + t0) * 1024 + col) = o2;
      if (has1) {
        uint2 o3;
        o3.x = pack2(v1[i].x * r1 * gs[i].x + shv[i].x, v1[i].y * r1 * gs[i].y + shv[i].y);
        o3.y = pack2(v1[i].z * r1 * gs[i].z + shv[i].z, v1[i].w * r1 * gs[i].w + shv[i].w);
        *reinterpret_cast<uint2*>(abuf + (size_t)(256 + t1) * 1024 + col) = o3;
      }
    }
  }
}

enum { EPI_GLA_IN = 0, EPI_RESID = 1, EPI_SWIGLU = 2, EPI_LRU_IN = 3, EPI_GATES = 4 };
struct GemmArgs {
  const u16* A; int lda; const u16* W; int K; int ntn; int rt0; int nrt;
  const float* src_ctx; const float* src_lat; float* dst_ctx; float* dst_lat; const float* gate_lat; int perm; int ctxsplit;
};
constexpr int G_BK = 64, G_HALF = 128, G_HT = G_HALF * G_BK;
__device__ __forceinline__ int lds_byte(int r, int c) {
  int st = (r >> 4) * 2 + (c >> 5), rr = r & 15, cc = c & 31, ob = rr * 64 + cc * 2;
  return st * 1024 + (ob ^ (((ob >> 9) & 1) << 5));
}
__device__ __forceinline__ void stage_rc(int b, int& R, int& C) {
  int st = b / 1024, sb = b % 1024, swz = sb ^ (((sb >> 9) & 1) << 5);
  R = (st >> 1) * 16 + swz / 64; C = (st & 1) * 32 + (swz % 64) / 2;
}

template <int WH> __device__ __forceinline__ int stage_tix(int r, int chunk) {
  if (WH == 64) return 16384 + r * 64 + ((chunk ^ (r & 7)) << 3);
  return (r < 128 ? 16384 : 49152) + (r & 127) * 128 + ((chunk ^ (r & 15)) << 3);
}

template <int EPI, int KC, int LDAC>
__device__ __forceinline__ void gemm_phase(const Params& p, const GemmArgs g, char* smem) {
  u16* shm = (u16*)smem;
#define SA(b, h) (shm + ((b) * 2 + (h)) * G_HT)
#define SB(b, h) (shm + (4 + (b) * 2 + (h)) * G_HT)
#define STAGE(P, BASE, LD, br, kt) do { const char* _gb = (const char*)((BASE) + (long)(br) * (LD) + (long)(kt) * G_BK); \
    for (int _i = 0; _i < 2; ++_i) { int _b = tid * 16 + _i * 8192; \
      __builtin_amdgcn_global_load_lds((const unsigned*)(_gb + ((LD) == lda ? offA[_i] : offB[_i])), \
        (__attribute__((address_space(3))) unsigned*)((char*)(P) + _b), 16, 0, 0); } } while (0)
#define LDA(dst, b, h) for (int m = 0; m < 4; ++m) for (int k = 0; k < 2; ++k) \
    dst[m][k] = *reinterpret_cast<const bf16x8*>((char*)SA(b, h) + lds_byte(wr * 64 + m * 16 + fr, k * 32 + fq * 8))
#define LDB(dst, b, h) for (int n = 0; n < 2; ++n) for (int k = 0; k < 2; ++k) \
    dst[n][k] = *reinterpret_cast<const bf16x8*>((char*)SB(b, h) + lds_byte(wc * 32 + n * 16 + fr, k * 32 + fq * 8))
#define MMA(ai, bj, At, Bt) do { __builtin_amdgcn_s_setprio(1); \
    for (int m = 0; m < 4; ++m) for (int n = 0; n < 2; ++n) for (int k = 0; k < 2; ++k) \
      acc[ai][bj][m][n] = __builtin_amdgcn_mfma_f32_16x16x32_bf16(At[m][k], Bt[n][k], acc[ai][bj][m][n], 0, 0, 0); \
    __builtin_amdgcn_s_setprio(0); } while (0)
#define WAIT_V(n) asm volatile("s_waitcnt vmcnt(" #n ")" ::: "memory")
#define WAIT_L(n) asm volatile("s_waitcnt lgkmcnt(" #n ")" ::: "memory")
#define BAR __builtin_amdgcn_s_barrier()
#define SCHED __builtin_amdgcn_sched_barrier(0)
  const int ntn = g.ntn, nrt = g.nrt, ntiles = nrt * ntn;
  constexpr int K = KC, lda = LDAC, ntfull = K / G_BK;
  const bool csplit = (EPI == EPI_RESID) && g.ctxsplit;
  const int nunits = ntiles + (csplit ? ntn * (K / 256) : 0);
  for (int t = blockIdx.x; t < nunits; t += gridDim.x) {
    const int tid = opaque_tid();
    const int wid = tid >> 6, lane = tid & 63, wr = wid >> 2, wc = wid & 3, fr = lane & 15, fq = lane >> 4;
    int brow, bcol, koff = 0, nt = ntfull;
    bool part = false;
    if (t < ntiles) {
      int x = t & 7, j = t >> 3, q = ntiles >> 3, r = ntiles & 7;
      int v = (x < r ? x * (q + 1) : r * (q + 1) + (x - r) * q) + j;
      int grp = v / (8 * ntn); int first = grp * 8; int gsz = min(8, nrt - first);
      int vo = v - grp * 8 * ntn;
      brow = (g.rt0 + first + vo % gsz) * 256; bcol = (vo / gsz) * 256;
    } else {
      const int u = t - ntiles;
      brow = 0; bcol = (u % ntn) * 256; koff = (u / ntn) * 256; nt = 4; part = true;
    }
    int acoff = 0;
    if (EPI == EPI_GATES) acoff = ((bcol & 2047) >> 9) * 256;
    const u16* A = g.A + acoff + koff;
    const u16* Bt = g.W + koff;
    f32x4 acc[2][2][4][2];
    bf16x8 At[4][2], B0[2][2], B1[2][2];
    unsigned offA[2], offB[2];
#pragma unroll
    for (int _i = 0; _i < 2; ++_i) { int _r, _c; stage_rc(tid * 16 + _i * 8192, _r, _c); offA[_i] = (unsigned)(_r * lda + _c) * 2u; offB[_i] = (unsigned)(_r * K + _c) * 2u; }
    constexpr bool PF = (EPI == EPI_SWIGLU || EPI == EPI_LRU_IN || EPI == EPI_GLA_IN);
    const bool prefetched = PF && (t != (int)blockIdx.x);
    if (!prefetched) {
      STAGE(SB(0, 0), Bt, K, bcol, 0); STAGE(SA(0, 0), A, lda, brow, 0);
      STAGE(SB(0, 1), Bt, K, bcol + G_HALF, 0); STAGE(SA(0, 1), A, lda, brow + G_HALF, 0);
    }
    if (wr == 1) BAR;
    if (prefetched) { WAIT_V(0); } else { WAIT_V(4); }
    BAR;
    STAGE(SB(1, 0), Bt, K, bcol, 1); STAGE(SA(1, 0), A, lda, brow, 1); STAGE(SB(1, 1), Bt, K, bcol + G_HALF, 1);
    WAIT_V(6); BAR;
#pragma unroll
    for (int a = 0; a < 2; ++a)
#pragma unroll
      for (int b = 0; b < 2; ++b)
#pragma unroll
        for (int m = 0; m < 4; ++m)
#pragma unroll
          for (int n = 0; n < 2; ++n) acc[a][b][m][n] = f32x4{0.f, 0.f, 0.f, 0.f};
    for (int t2 = 0; t2 < nt - 2; t2 += 2) {
      LDB(B0, 0, 0); SCHED; LDA(At, 0, 0); STAGE(SA(1, 1), A, lda, brow + G_HALF, t2 + 1);
      WAIT_L(8); BAR; WAIT_L(0); MMA(0, 0, At, B0); BAR; SCHED;
      LDB(B1, 0, 1); STAGE(SB(0, 0), Bt, K, bcol, t2 + 2);
      BAR; WAIT_L(0); MMA(0, 1, At, B1); BAR;
      LDA(At, 0, 1); STAGE(SA(0, 0), A, lda, brow, t2 + 2);
      BAR; WAIT_L(0); MMA(1, 0, At, B0); BAR; SCHED;
      STAGE(SB(0, 1), Bt, K, bcol + G_HALF, t2 + 2);
      WAIT_V(6); BAR; MMA(1, 1, At, B1); BAR;
      LDB(B0, 1, 0); SCHED; LDA(At, 1, 0); STAGE(SA(0, 1), A, lda, brow + G_HALF, t2 + 2);
      WAIT_L(8); BAR; WAIT_L(0); MMA(0, 0, At, B0); BAR; SCHED;
      LDB(B1, 1, 1); STAGE(SB(1, 0), Bt, K, bcol, t2 + 3);
      BAR; WAIT_L(0); MMA(0, 1, At, B1); BAR;
      LDA(At, 1, 1); STAGE(SA(1, 0), A, lda, brow, t2 + 3);
      BAR; WAIT_L(0); MMA(1, 0, At, B0); BAR; SCHED;
      STAGE(SB(1, 1), Bt, K, bcol + G_HALF, t2 + 3);
      WAIT_V(6); BAR; MMA(1, 1, At, B1); BAR;
    }
    { LDB(B0, 0, 0); LDA(At, 0, 0); STAGE(SA(1, 1), A, lda, brow + G_HALF, nt - 1);
      BAR; WAIT_L(0); MMA(0, 0, At, B0); BAR;
      LDB(B1, 0, 1); BAR; WAIT_L(0); MMA(0, 1, At, B1); BAR;
      LDA(At, 0, 1); WAIT_V(4); BAR; WAIT_L(0); MMA(1, 0, At, B0); MMA(1, 1, At, B1); BAR; }
    { LDB(B0, 1, 0); LDA(At, 1, 0); WAIT_V(2); BAR; WAIT_L(0); MMA(0, 0, At, B0); BAR;
      LDB(B1, 1, 1); WAIT_V(0); BAR; WAIT_L(0); MMA(0, 1, At, B1); BAR;
      LDA(At, 1, 1); BAR; WAIT_L(0); MMA(1, 0, At, B0); MMA(1, 1, At, B1); BAR; }
    if (wr == 0) BAR;
    if (PF) {
      const int tn_ = t + gridDim.x;
      if (tn_ < ntiles) {
        int x = tn_ & 7, j = tn_ >> 3, q = ntiles >> 3, r = ntiles & 7;
        int v = (x < r ? x * (q + 1) : r * (q + 1) + (x - r) * q) + j;
        int grp = v / (8 * ntn); int first = grp * 8; int gsz = min(8, nrt - first);
        int vo = v - grp * 8 * ntn;
        const int nbrow = (g.rt0 + first + vo % gsz) * 256, nbcol = (vo / gsz) * 256;
        STAGE(SB(0, 0), Bt, K, nbcol, 0); STAGE(SA(0, 0), A, lda, nbrow, 0);
        STAGE(SB(0, 1), Bt, K, nbcol + G_HALF, 0); STAGE(SA(0, 1), A, lda, nbrow + G_HALF, 0);
      }
    }
    char* ws = p.ws;
    const int tide = opaque_tid();
    const int wre = tide >> 8, wce = (tide >> 6) & 3, fre = tide & 15, fqe = (tide & 63) >> 4;
    const bool direct = (EPI == EPI_RESID) || (EPI == EPI_GLA_IN && ((bcol >= 1024 && bcol < 2048) || bcol >= 3072));
    if (direct) {
#pragma unroll
      for (int ai = 0; ai < 2; ++ai)
#pragma unroll
        for (int bj = 0; bj < 2; ++bj) {
          const int rbase = brow + ai * 128 + wre * 64 + fqe * 4;
          const int cbase = bcol + bj * 128 + wce * 32 + fre;
          if (EPI == EPI_GLA_IN) {
            if (bcol < 2048) {
              u16* vt = (u16*)(ws + OFF_VT);
#pragma unroll
              for (int m = 0; m < 4; ++m)
#pragma unroll
                for (int n = 0; n < 2; ++n) {
                  uint2 o2; o2.x = pack2(acc[ai][bj][m][n][0], acc[ai][bj][m][n][1]); o2.y = pack2(acc[ai][bj][m][n][2], acc[ai][bj][m][n][3]);
                  *reinterpret_cast<uint2*>(vt + (size_t)(cbase + n * 16 - 1024) * MR + rbase + m * 16) = o2;
                }
            } else {
              float* rb2 = (float*)(ws + OFF_R);
#pragma unroll
              for (int m = 0; m < 4; ++m)
#pragma unroll
                for (int n = 0; n < 2; ++n) {
                  int cl = cbase + n * 16 - 3072;
                  if (cl < 32) {
#pragma unroll
                    for (int j = 0; j < 4; ++j) rb2[(size_t)(rbase + m * 16 + j) * 32 + cl] = acc[ai][bj][m][n][j];
                  }
                }
            }
          } else if (EPI == EPI_RESID) {
            const bool isctx = brow < 256;
            const float* gate = isctx ? (g.gate_lat + 6144) : g.gate_lat;
            float gv[2];
#pragma unroll
            for (int n = 0; n < 2; ++n) gv[n] = gate[cbase + n * 16];
#pragma unroll
            for (int m = 0; m < 4; ++m)
#pragma unroll
              for (int j = 0; j < 4; ++j) {
                int dr = rbase + m * 16 + j;
                const float* sp; float* dp;
                if (isctx) { sp = g.src_ctx + (size_t)dr * 1024; dp = g.dst_ctx + (size_t)dr * 1024; }
                else { int tt = dr - 256; int lr = g.perm ? ((tt & 255) * 64 + (tt >> 8)) : tt; sp = g.src_lat + (size_t)lr * 1024; dp = g.dst_lat + (size_t)lr * 1024; }
#pragma unroll
                for (int n = 0; n < 2; ++n) {
                  int c = cbase + n * 16;
                  if (part) atomicAdd(dp + c, gv[n] * acc[ai][bj][m][n][j]);
                  else dp[c] = sp[c] + gv[n] * acc[ai][bj][m][n][j];
                }
              }
          }
        }
    } else {
      constexpr int WH = (EPI == EPI_SWIGLU || EPI == EPI_GATES) ? 64 : 128;
      constexpr bool SWZ = (EPI == EPI_SWIGLU || EPI == EPI_LRU_IN || EPI == EPI_GLA_IN);
      constexpr int LDW = WH + 8;
      constexpr int CPR = WH / 8;
      u16* T0 = (u16*)smem;
      u16* S0 = (u16*)smem;
      u16* T1 = T0 + 256 * LDW;
      u16* TU = T1 + 256 * LDW;
#pragma unroll
      for (int bj = 0; bj < 2; ++bj) {
        int chb = 0, gd = 0;
        float ba = 0.f, bx = 0.f, spl = 0.f;
        if (EPI == EPI_GATES) {
          gd = bcol >> 11;
          chb = ((bcol & 2047) >> 9) * 256 + ((bcol & 511) >> 5) * 16 + bj * 64;
          const u16* uc = (const u16*)(ws + OFF_ABUF);
#pragma unroll
          for (int i = 0; i < 4; ++i) {
            int id = tide + 512 * i, r = id >> 3, c = id & 7;
            *reinterpret_cast<uint4*>(TU + r * LDW + c * 8) = *reinterpret_cast<const uint4*>(uc + (size_t)(brow + r) * 1024 + chb + c * 8);
          }
          const int ch = chb + wce * 16 + fre;
          ba = p.in[18][gd * 1024 + ch]; bx = p.in[20][gd * 1024 + ch];
          spl = softplus_f(-p.in[21][gd * 1024 + ch]);
          __syncthreads();
        }
#pragma unroll
        for (int ai = 0; ai < 2; ++ai)
#pragma unroll
          for (int m = 0; m < 4; ++m)
#pragma unroll
            for (int j = 0; j < 4; ++j) {
              const int rowl = ai * 128 + wre * 64 + m * 16 + fqe * 4 + j;
              if (EPI == EPI_SWIGLU) {
                float a1 = acc[ai][bj][m][0][j], a3 = acc[ai][bj][m][1][j];
                S0[stage_tix<64>(rowl, wce * 2 + (fre >> 3)) + (fre & 7)] = f2bf(silu_f(a1) * a3);
              } else if (EPI == EPI_GATES) {
                float r = sigmoid_f(acc[ai][bj][m][0][j] + ba);
                float ig = sigmoid_f(acc[ai][bj][m][1][j] + bx);
                float la = -8.f * r * spl;
                float ucv = bf2f(TU[rowl * LDW + wce * 16 + fre]);
                float bbv = __fsqrt_rn(fmaxf(1.f - __expf(2.f * la), 0.f)) * ig * ucv;
                T0[rowl * LDW + wce * 16 + fre] = f2bf(la);
                T1[rowl * LDW + wce * 16 + fre] = f2bf(bbv);
              } else {
#pragma unroll
                for (int n = 0; n < 2; ++n) {
                  float v = acc[ai][bj][m][n][j];
                  if (EPI == EPI_LRU_IN && bcol < 1024) v = gelu_tanh(v);
                  S0[stage_tix<128>(rowl, wce * 4 + n * 2 + (fre >> 3)) + (fre & 7)] = f2bf(v);
                }
              }
            }
        __syncthreads();
        {
          u16* d0; u16* d1 = nullptr; size_t ld; int col0;
          if (EPI == EPI_SWIGLU) { d0 = (u16*)(ws + OFF_HID); ld = HID; col0 = (bcol >> 5) * 16 + bj * 64; }
          else if (EPI == EPI_GATES) { d0 = (u16*)(ws + OFF_LA) + (size_t)gd * MR * 1024; d1 = (u16*)(ws + OFF_BB) + (size_t)gd * MR * 1024; ld = 1024; col0 = chb; }
          else if (EPI == EPI_LRU_IN) { d0 = (u16*)(ws + (bcol < 1024 ? OFF_Y : OFF_U)); ld = 1024; col0 = (bcol & 1023) + bj * 128; }
          else {
            if (bcol < 1024) { d0 = (u16*)(ws + (bcol < 512 ? OFF_Q0 : OFF_K0)); d1 = (u16*)(ws + (bcol < 512 ? OFF_Q1 : OFF_K1)); ld = 512; col0 = (bcol & 511) + bj * 128; }
            else { d0 = (u16*)(ws + OFF_G); ld = 1024; col0 = bcol - 2048 + bj * 128; }
          }
#pragma unroll
          for (int i = 0; i < 256 * CPR / 512; ++i) {
            int id = tide + 512 * i, r = id / CPR, c = id % CPR;
            uint4 v = *reinterpret_cast<const uint4*>(SWZ ? (S0 + stage_tix<WH>(r, c)) : (T0 + r * LDW + c * 8));
            size_t o = (size_t)(brow + r) * ld + col0 + c * 8;
            *reinterpret_cast<uint4*>(d0 + o) = v;
            if (EPI == EPI_GATES) { uint4 v1 = *reinterpret_cast<const uint4*>(T1 + r * LDW + c * 8); *reinterpret_cast<uint4*>(d1 + o) = v1; }
            else if (EPI == EPI_GLA_IN) { if (d1) *reinterpret_cast<uint4*>(d1 + o) = v; }
          }
        }
        __syncthreads();
      }
    }
    if (direct) __syncthreads();
  }
#undef SA
#undef SB
#undef STAGE
#undef LDA
#undef LDB
#undef MMA
#undef WAIT_V
#undef WAIT_L
#undef BAR
#undef SCHED
}

__device__ __forceinline__ void phase_gla_a(const Params& p, char* smem) {
  const int tid0 = opaque_tid(); const int tid = tid0 & 255, lane = tid & 63, wave = tid >> 6, l15 = lane & 15, l4 = lane >> 4;
  const int vhalf = __builtin_amdgcn_readfirstlane(tid0 >> 8);
  smem += vhalf * 65536;
  u16* sKT = (u16*)smem;
  u16* sV = sKT + 128 * LDT;
  float* sDec = (float*)(sV + 128 * LDT);
  float* sR = sDec + 256;
  char* ws = p.ws;
  const u16* VT = (const u16*)(ws + OFF_VT);
  const float* R = (const float*)(ws + OFF_R);
  for (int base = 0; base < 260; base += 2 * gridDim.x) {
    const int it0 = base + blockIdx.x + gridDim.x * vhalf;
    const bool active = it0 < 260;
    if (!active) {
      const int q = it0 - 260;
      float* tile = (float*)smem;
      for (int i = 0; i < 17; ++i) {
        const int dt = q * 17 + i;
        const bool act = (q >= 0) && dt < NDEFER_TILES && base == 0;
        int rem = act ? dt : 0; int j = 4; TJob t = get_job(p, 4);
        for (;;) {
          if (!job_is_early(j)) { int nt_ = (t.K >> 6) * ((t.N + 63) >> 6); if (rem < nt_) break; rem -= nt_; }
          ++j; if (j >= NJOBS) { j = 4; rem = 0; t = get_job(p, 4); break; }
          t = get_job(p, j);
        }
        prep_tile(t, rem, act, tile, tid);
      }
      __syncthreads();
      continue;
    }
    const int it = it0;
    const int pc = it >> 2, dir = (it >> 1) & 1, hp = it & 1;
    const int lc = dir ? (pc == 0 ? 0 : 65 - pc) : pc;
    u16* Q = (u16*)(ws + (dir ? OFF_Q1 : OFF_Q0));
    u16* Kb = (u16*)(ws + (dir ? OFF_K1 : OFF_K0));
    {
      const int h2 = tid >> 7, ch = tid & 127, head = hp * 2 + h2;
      {
        const float4* rsrc = reinterpret_cast<const float4*>(R + (size_t)(pc * 256 + tid) * 32 + dir * 16);
        float4* rdst = reinterpret_cast<float4*>(sR + tid * 16);
        rdst[0] = rsrc[0]; rdst[1] = rsrc[1]; rdst[2] = rsrc[2]; rdst[3] = rsrc[3];
      }
      float w2[16];
#pragma unroll
      for (int m = 0; m < 16; ++m) w2[m] = p.in[10][(dir * 16 + m) * 512 + head * 128 + ch];
      const float gbv = p.in[11][dir * 512 + head * 128 + ch];
      __syncthreads();
      float B = 0.f;
#define GLA_QK_LOAD(t8_, qd, kd) { _Pragma("unroll") for (int s = 0; s < 8; ++s) { \
          int lp = (t8_) * 8 + s; int ip = dir ? 255 - lp : lp; \
          size_t o = (size_t)(pc * 256 + ip) * 512 + head * 128 + ch; qd[s] = Q[o]; kd[s] = Kb[o]; } }
#define GLA_QK_COMP(t8_, qd, kd) { _Pragma("unroll") for (int s = 0; s < 8; ++s) { \
          int lp = (t8_) * 8 + s; int ip = dir ? 255 - lp : lp; \
          const float4* rr = reinterpret_cast<const float4*>(sR + ip * 16); \
          float z = gbv; \
          _Pragma("unroll") for (int m4 = 0; m4 < 4; ++m4) { float4 r4 = rr[m4]; \
            z += r4.x * w2[m4 * 4] + r4.y * w2[m4 * 4 + 1] + r4.z * w2[m4 * 4 + 2] + r4.w * w2[m4 * 4 + 3]; } \
          B -= __logf(1.f + __expf(-z)) * (1.f / 16.f); \
          if (active) { size_t o = (size_t)(pc * 256 + ip) * 512 + head * 128 + ch; const float eB = __expf(B); \
            Q[o] = f2bf(bf2f(qd[s]) * eB); Kb[o] = f2bf(bf2f(kd[s]) * __frcp_rn(eB)); } } }
      {
        u16 qa[8], ka[8], qb[8], kb[8];
        GLA_QK_LOAD(0, qa, ka)
        for (int t16 = 0; t16 < 16; ++t16) {
          GLA_QK_LOAD(2 * t16 + 1, qb, kb)
          GLA_QK_COMP(2 * t16, qa, ka)
          { const int tn = t16 < 15 ? 2 * t16 + 2 : 31; GLA_QK_LOAD(tn, qa, ka) }
          GLA_QK_COMP(2 * t16 + 1, qb, kb)
        }
      }
      const float dec = __expf(B);
      sDec[tid] = dec;
      if (active) ((float*)(ws + OFF_DEC))[((dir * 65 + lc) * 4 + head) * 128 + ch] = dec;
    }
    __threadfence_block();
    __syncthreads();
    {
      f32x4 acc[2][8];
#pragma unroll
      for (int m = 0; m < 2; ++m)
#pragma unroll
        for (int n = 0; n < 8; ++n) acc[m][n] = f32x4{0.f, 0.f, 0.f, 0.f};
#define GLA_LK(i, dst) { dst = *reinterpret_cast<const uint4*>(kp_ + (i) * 16 * 512); }
#define GLA_LV(i, dst) { dst = *reinterpret_cast<const uint4*>(vp_ + (size_t)((i) * 32) * MR); }
#define GLA_GLOAD(st_) do { \
        const int h2_ = (st_) >> 3, dvh_ = ((st_) >> 2) & 1, tb_ = (st_) & 3, head_ = hp * 2 + h2_; \
        const int rowb_ = pc * 256 + tb_ * 64; \
        const u16* kp_ = Kb + (size_t)rowb_ * 512 + head_ * 128 + (unsigned)((tid >> 4) * 512 + (tid & 15) * 8); \
        const u16* vp_ = VT + (size_t)(head_ * 256 + dvh_ * 128) * MR + rowb_ + (unsigned)((tid >> 3) * MR + (tid & 7) * 8); \
        GLA_LK(0, rk0) GLA_LK(1, rk1) GLA_LK(2, rk2) GLA_LK(3, rk3) GLA_LV(0, rv0) GLA_LV(1, rv1) GLA_LV(2, rv2) GLA_LV(3, rv3) \
      } while (0)
#define GLA_SK(i, src) { int id = tid + 256 * (i), tok = id >> 4, c = id & 15; const uint4 kq = src; \
          const int cs_ = (((tok >> 3) ^ (c & 7)) << 3) + (tok & 7);     \
          sKT[(c * 8 + 0) * LDT + cs_] = (u16)(kq.x & 0xffff); sKT[(c * 8 + 1) * LDT + cs_] = (u16)(kq.x >> 16); \
          sKT[(c * 8 + 2) * LDT + cs_] = (u16)(kq.y & 0xffff); sKT[(c * 8 + 3) * LDT + cs_] = (u16)(kq.y >> 16); \
          sKT[(c * 8 + 4) * LDT + cs_] = (u16)(kq.z & 0xffff); sKT[(c * 8 + 5) * LDT + cs_] = (u16)(kq.z >> 16); \
          sKT[(c * 8 + 6) * LDT + cs_] = (u16)(kq.w & 0xffff); sKT[(c * 8 + 7) * LDT + cs_] = (u16)(kq.w >> 16); }
#define GLA_SV(i, src) { int id = tid + 256 * (i), r = id >> 3, c = id & 7; *reinterpret_cast<uint4*>(sV + r * LDT + c * 8) = src; }
      uint4 rk0, rk1, rk2, rk3, rv0, rv1, rv2, rv3;
      GLA_GLOAD(0);
      for (int st = 0; st < 16; ++st) {
        GLA_SK(0, rk0) GLA_SK(1, rk1) GLA_SK(2, rk2) GLA_SK(3, rk3)
        GLA_SV(0, rv0) GLA_SV(1, rv1) GLA_SV(2, rv2) GLA_SV(3, rv3)
        __syncthreads();
        GLA_GLOAD(st < 15 ? st + 1 : 15);
#pragma unroll
        for (int kk = 0; kk < 2; ++kk) {
          bf16x8 af[2];
#pragma unroll
          for (int m = 0; m < 2; ++m) af[m] = lds_frag(sV, (wave * 32 + m * 16 + l15) * LDT + kk * 32 + l4 * 8);
#pragma unroll
          for (int n = 0; n < 8; ++n) {
            bf16x8 b = lds_frag(sKT, (n * 16 + l15) * LDT + (((kk * 4 + l4) ^ ((n * 2 + (l15 >> 3)) & 7)) << 3));
#pragma unroll
            for (int m = 0; m < 2; ++m) acc[m][n] = mfma16(af[m], b, acc[m][n]);
          }
        }
        __syncthreads();
        if ((st & 3) == 3) {
          const int h2 = st >> 3, dvh = (st >> 2) & 1, head = hp * 2 + h2;
          u16* UT = (u16*)(ws + OFF_UT) + (size_t)((dir * 65 + lc) * 4 + head) * 32768;
#pragma unroll
          for (int n = 0; n < 8; ++n) {
            int dk = n * 16 + l15; float dd = sDec[h2 * 128 + dk];
#pragma unroll
            for (int m = 0; m < 2; ++m) {
              if (active) {
#pragma unroll
                for (int j = 0; j < 4; ++j) {
                  int dv = dvh * 128 + wave * 32 + m * 16 + l4 * 4 + j;
                  UT[dv * 128 + dk] = f2bf(acc[m][n][j] * dd);
                }
              }
              acc[m][n] = f32x4{0.f, 0.f, 0.f, 0.f};
            }
          }
        }
      }
    }
    __syncthreads();
  }
}

__device__ __forceinline__ void phase_gla_scan(const Params& p) {
  char* ws = p.ws;
  const float* DEC = (const float*)(ws + OFF_DEC);
  for (int idx = blockIdx.x * NTHR + opaque_tid(); idx < 131072; idx += gridDim.x * NTHR) {
    int e = idx * 2; int dir = e >> 17; int head = (e >> 15) & 3; int w = e & 32767; int dk = w & 127;
    float s0 = 0.f, s1 = 0.f;
    for (int lb = 0; lb < 65; lb += 13) {
      unsigned u[13]; float d0[13], d1[13];
#pragma unroll
      for (int i = 0; i < 13; ++i) {
        int lc = lb + i;
        u[i] = *reinterpret_cast<const unsigned*>((u16*)(ws + OFF_UT) + (size_t)((dir * 65 + lc) * 4 + head) * 32768 + w);
        float2 dd = *reinterpret_cast<const float2*>(DEC + ((dir * 65 + lc) * 4 + head) * 128 + dk);
        d0[i] = dd.x; d1[i] = dd.y;
      }
#pragma unroll
      for (int i = 0; i < 13; ++i) {
        int lc = lb + i;
        *reinterpret_cast<unsigned*>((u16*)(ws + OFF_UT) + (size_t)((dir * 65 + lc) * 4 + head) * 32768 + w) = pack2(s0, s1);
        s0 = d0[i] * s0 + bf2f((u16)(u[i] & 0xffff));
        s1 = d1[i] * s1 + bf2f((u16)(u[i] >> 16));
      }
    }
  }
}

__device__ __forceinline__ void phase_gla_b(const Params& p, char* smem) {
  const int vhalf = __builtin_amdgcn_readfirstlane(opaque_tid() >> 8);
  smem += vhalf * 65536;
  u16* sK = (u16*)smem;
  u16* sB = sK + 64 * LDK;
  u16* sP = sB + 256 * LDT;
  char* ws = p.ws;
  const u16* VT = (const u16*)(ws + OFF_VT);
  for (int it = blockIdx.x * 2 + vhalf; it < 1040; it += gridDim.x * 2) {
    const int pc = it >> 4, head = (it >> 2) & 3, ib = it & 3;
    const int tid = opaque_tid() & 255, lane = tid & 63, wave = tid >> 6, l15 = lane & 15, l4 = lane >> 4;
    f32x4 o[16];
#pragma unroll
    for (int n = 0; n < 16; ++n) o[n] = f32x4{0.f, 0.f, 0.f, 0.f};
    const int n0 = 3 + ib;
    uint4 vb0, vb1, vb2, vb3, vb4, vb5, vb6, vb7, kb0, kb1, kb2, kb3;
    bf16x8 qf[4];
#define GLB_LV(i, dst) { dst = *reinterpret_cast<const uint4*>(bp + (size_t)((i) * 32) * bstride); }
#define GLB_LK(i, dst) { dst = *reinterpret_cast<const uint4*>(kp + (i) * 16 * 512); }
#define GLB_PREFETCH(s_) do { \
      const int d_ = (s_) >= n0, ls_ = (s_) - d_ * n0; \
      const int lc_ = d_ ? (pc == 0 ? 0 : 65 - pc) : pc; \
      const u16* bsrc; int bstride; \
      if (ls_ < 2) { bsrc = (const u16*)(ws + OFF_UT) + (size_t)((d_ * 65 + lc_) * 4 + head) * 32768 + ls_ * 64; bstride = 128; } \
      else { const int jb_ = d_ ? ib + ls_ - 2 : ls_ - 2; bsrc = VT + (size_t)(head * 256) * MR + pc * 256 + jb_ * 64; bstride = MR; \
        const u16* ksrc = (const u16*)(ws + (d_ ? OFF_K1 : OFF_K0)) + (size_t)(pc * 256 + jb_ * 64) * 512 + head * 128; \
        const u16* kp = ksrc + (unsigned)((tid >> 4) * 512 + (tid & 15) * 8); \
        GLB_LK(0, kb0) GLB_LK(1, kb1) GLB_LK(2, kb2) GLB_LK(3, kb3) } \
      const u16* bp = bsrc + (unsigned)((tid >> 3) * bstride + (tid & 7) * 8); \
      GLB_LV(0, vb0) GLB_LV(1, vb1) GLB_LV(2, vb2) GLB_LV(3, vb3) GLB_LV(4, vb4) GLB_LV(5, vb5) GLB_LV(6, vb6) GLB_LV(7, vb7) \
    } while (0)
#define GLB_SV(i, src) { int id = tid + 256 * (i), r = id >> 3, c = id & 7; *reinterpret_cast<uint4*>(sB + r * LDT + c * 8) = src; }
#define GLB_SK(i, src) { int id = tid + 256 * (i), r = id >> 4, c = id & 15; *reinterpret_cast<uint4*>(sK + r * LDK + c * 8) = src; }
#define GLB_LQ(d_) { const u16* qrow = (const u16*)(ws + ((d_) ? OFF_Q1 : OFF_Q0)) + (size_t)(pc * 256 + ib * 64 + wave * 16 + l15) * 512 + head * 128 + l4 * 8; \
      _Pragma("unroll") for (int ks = 0; ks < 4; ++ks) qf[ks] = *reinterpret_cast<const bf16x8*>(qrow + ks * 32); }
    GLB_LQ(0)
    const int sskip = (pc == 0) ? 2 : 0;
    int st = sskip;
    GLB_PREFETCH(st);
    while (st < 9) {
      const int dir = st >= n0, ls = st - dir * n0;
      GLB_SV(0, vb0) GLB_SV(1, vb1) GLB_SV(2, vb2) GLB_SV(3, vb3) GLB_SV(4, vb4) GLB_SV(5, vb5) GLB_SV(6, vb6) GLB_SV(7, vb7)
      if (ls >= 2) { GLB_SK(0, kb0) GLB_SK(1, kb1) GLB_SK(2, kb2) GLB_SK(3, kb3) }
      if (st == n0 + sskip) GLB_LQ(1)
      int snx = st + 1; if (snx == n0) snx += sskip;
      { const int sn = snx < 8 ? snx : 8; GLB_PREFETCH(sn); }
      __syncthreads();
      if (ls < 2) {
#pragma unroll
        for (int kk = 0; kk < 2; ++kk) {
          const bf16x8 a = (ls == 0) ? (kk == 0 ? qf[0] : qf[1]) : (kk == 0 ? qf[2] : qf[3]);
#pragma unroll
          for (int n = 0; n < 16; ++n) {
            bf16x8 b = lds_frag(sB, (n * 16 + l15) * LDT + kk * 32 + l4 * 8);
            o[n] = mfma16(a, b, o[n]);
          }
        }
      } else {
        const int jb = dir ? ib + ls - 2 : ls - 2;
        f32x4 sc[4];
#pragma unroll
        for (int n = 0; n < 4; ++n) sc[n] = f32x4{0.f, 0.f, 0.f, 0.f};
#pragma unroll
        for (int ks = 0; ks < 4; ++ks)
#pragma unroll
          for (int n = 0; n < 4; ++n) {
            bf16x8 b = lds_frag(sK, (n * 16 + l15) * LDK + ks * 32 + l4 * 8);
            sc[n] = mfma16(qf[ks], b, sc[n]);
          }
        const bool diag = (jb == ib);
#pragma unroll
        for (int n = 0; n < 4; ++n)
#pragma unroll
          for (int j = 0; j < 4; ++j) {
            int ii = wave * 16 + l4 * 4 + j, jj = n * 16 + l15;
            float v = sc[n][j];
            if (diag) { bool keep = dir ? (jj >= ii) : (jj <= ii); v = keep ? v : 0.f; }
            sP[ii * LDT + jj] = f2bf(v);
          }
        asm volatile("s_waitcnt lgkmcnt(0)" ::: "memory");
#pragma unroll
        for (int kk = 0; kk < 2; ++kk) {
          bf16x8 a = lds_frag(sP, (wave * 16 + l15) * LDT + kk * 32 + l4 * 8);
#pragma unroll
          for (int n = 0; n < 16; ++n) {
            bf16x8 b = lds_frag(sB, (n * 16 + l15) * LDT + kk * 32 + l4 * 8);
            o[n] = mfma16(a, b, o[n]);
          }
        }
      }
      __syncthreads();
      st = snx;
    }
    const u16* G = (const u16*)(ws + OFF_G);
    u16* og = (u16*)(ws + OFF_ABUF);
    const float* hn = p.in[12];
#pragma unroll
    for (int j = 0; j < 4; ++j) {
      float ss = 0.f;
#pragma unroll
      for (int n = 0; n < 16; ++n) ss += o[n][j] * o[n][j];
      ss += __shfl_xor(ss, 1); ss += __shfl_xor(ss, 2); ss += __shfl_xor(ss, 4); ss += __shfl_xor(ss, 8);
      const float rstd = rsqrtf(ss * (1.f / 256.f) + 1e-6f);
      const size_t row = (size_t)(pc * 256 + ib * 64 + wave * 16 + l4 * 4 + j);
#pragma unroll
      for (int n = 0; n < 16; ++n) {
        int dv = n * 16 + l15;
        float gv = bf2f(G[row * 1024 + head * 256 + dv]);
        og[row * 1024 + head * 256 + dv] = f2bf(o[n][j] * rstd * hn[dv] * silu_f(gv));
      }
    }
  }
}

__device__ __forceinline__ void phase_conv(const Params& p) {
  const u16* U = (const u16*)(p.ws + OFF_U);
  u16* uc = (u16*)(p.ws + OFF_ABUF);
  const float* cw = p.in[15]; const float* cb = p.in[16];
  for (int idx = blockIdx.x * NTHR + opaque_tid(); idx < MR * 128; idx += gridDim.x * NTHR) {
    const int row = idx >> 7, c = idx & 127, ch0 = c * 8;
    const int lo = row < 256 ? 0 : 256, hi = row < 256 ? 255 : MR - 1;
    float a[8];
#pragma unroll
    for (int e = 0; e < 8; ++e) a[e] = cb[ch0 + e];
#pragma unroll
    for (int j = 0; j < 4; ++j) {
      int rr = row + j - 2;
      if (rr >= lo && rr <= hi) {
        uint4 v = *reinterpret_cast<const uint4*>(U + (size_t)rr * 1024 + ch0);
        unsigned w[4] = {v.x, v.y, v.z, v.w};
#pragma unroll
        for (int e = 0; e < 4; ++e) {
          a[2 * e] += cw[j * 1024 + ch0 + 2 * e] * bf2f((u16)(w[e] & 0xffff));
          a[2 * e + 1] += cw[j * 1024 + ch0 + 2 * e + 1] * bf2f((u16)(w[e] >> 16));
        }
      }
    }
    uint4 o; o.x = pack2(a[0], a[1]); o.y = pack2(a[2], a[3]); o.z = pack2(a[4], a[5]); o.w = pack2(a[6], a[7]);
    *reinterpret_cast<uint4*>(uc + (size_t)row * 1024 + ch0) = o;
  }
}

__device__ __forceinline__ void seg_geom(int it, int& seg, int& chg, int& row0, int& nrow) {
  if (it < 512) { seg = 8 + (it >> 2); chg = it & 3; row0 = 256 + (seg - 8) * 128; nrow = 128; }
  else { int u = it - 512; seg = u >> 2; chg = u & 3; row0 = seg * 32; nrow = 32; }
}
__device__ __forceinline__ int seg_lidx(int dir, int seg) { return dir ? (seg < 8 ? 7 - seg : 143 - seg) : seg; }

__device__ __forceinline__ void phase_scan_a(const Params& p) {
  const int tid0 = opaque_tid(); const int tid = tid0 & 255;
  const int vhalf = __builtin_amdgcn_readfirstlane(tid0 >> 8);
  char* ws = p.ws;
  float* AGG = (float*)(ws + OFF_AGG);
  for (int it = blockIdx.x * 2 + vhalf; it < 544; it += gridDim.x * 2) {
    int seg, chg, row0, nrow; seg_geom(it, seg, chg, row0, nrow);
    const int dir = tid >> 7, cp = tid & 127;
    const int ch = chg * 256 + cp * 2;
    const u16* LA = (const u16*)(ws + OFF_LA) + (size_t)dir * MR * 1024 + ch;
    const u16* BB = (const u16*)(ws + OFF_BB) + (size_t)dir * MR * 1024 + ch;
    float P0 = 0.f, P1 = 0.f, h0 = 0.f, h1 = 0.f;
    for (int ib = 0; ib < nrow; ib += 16) {
      unsigned la[16], bb[16];
#pragma unroll
      for (int i = 0; i < 16; ++i) {
        int ii = ib + i; int row = row0 + (dir ? nrow - 1 - ii : ii);
        la[i] = *reinterpret_cast<const unsigned*>(LA + (size_t)row * 1024);
        bb[i] = *reinterpret_cast<const unsigned*>(BB + (size_t)row * 1024);
      }
#pragma unroll
      for (int i = 0; i < 16; ++i) {
        float l0 = bf2f((u16)(la[i] & 0xffff)), l1 = bf2f((u16)(la[i] >> 16));
        P0 += l0; P1 += l1;
        h0 = __expf(l0) * h0 + bf2f((u16)(bb[i] & 0xffff));
        h1 = __expf(l1) * h1 + bf2f((u16)(bb[i] >> 16));
      }
    }
    const int lidx = seg_lidx(dir, seg);
    float* ap = AGG + (size_t)(dir * 2 + 0) * NSEG * 1024 + lidx * 1024 + ch;
    float* ah = AGG + (size_t)(dir * 2 + 1) * NSEG * 1024 + lidx * 1024 + ch;
    ap[0] = P0; ap[1] = P1; ah[0] = h0; ah[1] = h1;
  }
}

__device__ __forceinline__ float seg_carry(const float* ap, const float* ah, int lidx) {
  float h = 0.f;
  for (int lb = 0; lb < lidx; lb += 16) {
    float pa[16], ha[16];
#pragma unroll
    for (int i = 0; i < 16; ++i) { int l = min(lb + i, lidx - 1); pa[i] = ap[l * 1024]; ha[i] = ah[l * 1024]; }
#pragma unroll
    for (int i = 0; i < 16; ++i) { if (lb + i < lidx) h = __expf(pa[i]) * h + ha[i]; }
  }
  return h;
}

__device__ __forceinline__ void phase_scan_c(const Params& p, char* smem) {
  const int tid0 = opaque_tid(); const int tid = tid0 & 255;
  const int vhalf = __builtin_amdgcn_readfirstlane(tid0 >> 8);
  char* ws = p.ws;
  u16* sHF = (u16*)(smem + vhalf * 65536);
  const float* AGG = (const float*)(ws + OFF_AGG);
  const u16* Y = (const u16*)(ws + OFF_Y);
  u16* outA = (u16*)(ws + OFF_ABUF);
  for (int it = blockIdx.x * 2 + vhalf; it < 544; it += gridDim.x * 2) {
    int seg, chg, row0, nrow; seg_geom(it, seg, chg, row0, nrow);
    const int ch = chg * 256 + tid;
    {
      float h = seg_carry(AGG + (size_t)0 * NSEG * 1024 + ch, AGG + (size_t)1 * NSEG * 1024 + ch, seg);
      const u16* LA = (const u16*)(ws + OFF_LA) + ch;
      const u16* BB = (const u16*)(ws + OFF_BB) + ch;
      for (int ib = 0; ib < nrow; ib += 16) {
        u16 la[16], bb[16];
#pragma unroll
        for (int i = 0; i < 16; ++i) { size_t row = (size_t)(row0 + ib + i); la[i] = LA[row * 1024]; bb[i] = BB[row * 1024]; }
#pragma unroll
        for (int i = 0; i < 16; ++i) { h = __expf(bf2f(la[i])) * h + bf2f(bb[i]); sHF[(ib + i) * 256 + tid] = f2bf(h); }
      }
    }
    {
      const int lidx = seg_lidx(1, seg);
      float h = seg_carry(AGG + (size_t)2 * NSEG * 1024 + ch, AGG + (size_t)3 * NSEG * 1024 + ch, lidx);
      const u16* LA = (const u16*)(ws + OFF_LA) + (size_t)MR * 1024 + ch;
      const u16* BB = (const u16*)(ws + OFF_BB) + (size_t)MR * 1024 + ch;
      for (int ib = 0; ib < nrow; ib += 16) {
        u16 la[16], bb[16], yv[16];
#pragma unroll
        for (int i = 0; i < 16; ++i) { size_t row = (size_t)(row0 + nrow - 1 - ib - i); la[i] = LA[row * 1024]; bb[i] = BB[row * 1024]; yv[i] = Y[row * 1024 + ch]; }
#pragma unroll
        for (int i = 0; i < 16; ++i) {
          int ii = nrow - 1 - ib - i;
          h = __expf(bf2f(la[i])) * h + bf2f(bb[i]);
          float hf = bf2f(sHF[ii * 256 + tid]);
          outA[(size_t)(row0 + ii) * 1024 + ch] = f2bf((hf + h) * bf2f(yv[i]));
        }
      }
    }
  }
}

__device__ __forceinline__ void phase_final(const Params& p) {
  const int tid_ = opaque_tid(); const int lane = tid_ & 63, wave = tid_ >> 6;
  const float* gvec = p.in[26];
  float4 g[4];
#pragma unroll
  for (int i = 0; i < 4; ++i) g[i] = *reinterpret_cast<const float4*>(gvec + i * 256 + lane * 4);
  const int gw = blockIdx.x * 8 + wave, nw = gridDim.x * 8;
  for (int r0 = gw; r0 < 16384; r0 += 2 * nw) {
    const int r1 = r0 + nw; const bool has1 = r1 < 16384;
    float* s0 = p.out + (size_t)r0 * 1024;
    float* s1 = p.out + (size_t)(has1 ? r1 : r0) * 1024;
    float4 v0[4], v1[4]; float ss0 = 0.f, ss1 = 0.f;
#pragma unroll
    for (int i = 0; i < 4; ++i) { v0[i] = *reinterpret_cast<const float4*>(s0 + i * 256 + lane * 4); v1[i] = *reinterpret_cast<const float4*>(s1 + i * 256 + lane * 4); }
#pragma unroll
    for (int i = 0; i < 4; ++i) {
      ss0 += v0[i].x * v0[i].x + v0[i].y * v0[i].y + v0[i].z * v0[i].z + v0[i].w * v0[i].w;
      ss1 += v1[i].x * v1[i].x + v1[i].y * v1[i].y + v1[i].z * v1[i].z + v1[i].w * v1[i].w;
    }
#pragma unroll
    for (int o = 32; o >= 1; o >>= 1) { ss0 += __shfl_xor(ss0, o); ss1 += __shfl_xor(ss1, o); }
    const float q0 = rsqrtf(ss0 * (1.f / 1024.f) + 1e-6f), q1 = rsqrtf(ss1 * (1.f / 1024.f) + 1e-6f);
#pragma unroll
    for (int i = 0; i < 4; ++i) {
      int col = i * 256 + lane * 4;
      float4 o; o.x = v0[i].x * q0 * g[i].x; o.y = v0[i].y * q0 * g[i].y; o.z = v0[i].z * q0 * g[i].z; o.w = v0[i].w * q0 * g[i].w;
      *reinterpret_cast<float4*>(s0 + col) = o;
      if (has1) {
        float4 o1; o1.x = v1[i].x * q1 * g[i].x; o1.y = v1[i].y * q1 * g[i].y; o1.z = v1[i].z * q1 * g[i].z; o1.w = v1[i].w * q1 * g[i].w;
        *reinterpret_cast<float4*>(s1 + col) = o1;
      }
    }
  }
}

#define XB_TMO      128
#define XB_XCNT(j)  (256  + 64 * (j))
#define XB_XSUB(j)  (1280 + 64 * (j))
#define XB_XGEN(j)  (2304 + 64 * (j))
#define XB_TOP      3328
#define XB_TOPGEN   3392
#define XCD_BAR_WORDS 3456
#define XB_SPIN_CAP (1u << 22)
#define LAS __attribute__((address_space(3)))
__device__ __forceinline__ unsigned xb_ld(unsigned* p)              { return __hip_atomic_load(p, __ATOMIC_RELAXED, __HIP_MEMORY_SCOPE_AGENT); }
__device__ __forceinline__ unsigned xb_add(unsigned* p, unsigned v) { return __hip_atomic_fetch_add(p, v, __ATOMIC_RELAXED, __HIP_MEMORY_SCOPE_AGENT); }
__device__ __forceinline__ unsigned xb_xcc_id() { return (unsigned)__builtin_amdgcn_s_getreg((3 << 11) | 20) & 0xFu; }
#define XB_SPIN(cond, bar) do { unsigned _sp = 0; while (cond) { \
    if ((++_sp & 255u) == 0u) { if (xb_ld(&(bar)[XB_TMO])) break; if (_sp > XB_SPIN_CAP) { atomicAdd(&(bar)[XB_TMO], 1u); break; } } } } while (0)
struct XcdBarrier { unsigned* bar; unsigned x; volatile LAS unsigned* st; };
__device__ __forceinline__ XcdBarrier xcd_barrier_post(unsigned* bar, volatile LAS unsigned* st) {
    XcdBarrier b; b.bar = bar; b.x = xb_xcc_id(); b.st = st;
    if (threadIdx.x == 0) (void)xb_add(&bar[XB_XCNT(b.x)], 1u);
    return b;
}
__device__ __forceinline__ void xcd_barrier_complete(unsigned* bar, unsigned x, unsigned& nloc, unsigned& nx) {
    const unsigned G = gridDim.x * gridDim.y * gridDim.z;
    unsigned sum, cnt, mine, sp = 0u;
    for (;;) {
        sum = 0u; cnt = 0u; mine = 0u;
#pragma unroll
        for (unsigned j = 0; j < 16; ++j) { const unsigned c = xb_ld(&bar[XB_XCNT(j)]); sum += c; cnt += (c > 0u) ? 1u : 0u; mine = (j == x) ? c : mine; }
        if (sum == G) break;
        __builtin_amdgcn_s_sleep(1);
        if ((++sp & 255u) == 0u) { if (xb_ld(&bar[XB_TMO])) break; if (sp > XB_SPIN_CAP) { atomicAdd(&bar[XB_TMO], 1u); break; } }
    }
    nloc = mine > 0u ? mine : 1u; nx = cnt > 0u ? cnt : 1u;
}
__device__ __forceinline__ void xcd_barrier_(const XcdBarrier& b) {
    asm volatile("s_waitcnt vmcnt(0)" ::: "memory");
    __syncthreads();
    if (threadIdx.x == 0) {
        unsigned* bar = b.bar;
        __builtin_amdgcn_s_waitcnt(0);
        unsigned nloc = b.st[0], nx = b.st[1];
        if (nloc == 0u) { xcd_barrier_complete(bar, b.x, nloc, nx); b.st[0] = nloc; b.st[1] = nx; }
        const unsigned old = xb_add(&bar[XB_XSUB(b.x)], 1u);
        const unsigned gen = old / nloc;
        if (old + 1u == (gen + 1u) * nloc) {
            __builtin_amdgcn_fence(__ATOMIC_RELEASE, "agent");
            asm volatile("s_waitcnt vmcnt(0)" ::: "memory");
            const unsigned og = xb_add(&bar[XB_TOP], 1u);
            const unsigned tg = og / nx;
            if (og + 1u == (tg + 1u) * nx) xb_add(&bar[XB_TOPGEN], 1u);
            else XB_SPIN(xb_ld(&bar[XB_TOPGEN]) == tg, bar);
            __builtin_amdgcn_fence(__ATOMIC_ACQUIRE, "agent");
            xb_add(&bar[XB_XGEN(b.x)], 1u);
            asm volatile("s_waitcnt vmcnt(0)" ::: "memory");
        } else {
            XB_SPIN(xb_ld(&bar[XB_XGEN(b.x)]) == gen, bar);
            __builtin_amdgcn_fence(__ATOMIC_ACQUIRE, "agent");
            asm volatile("s_waitcnt vmcnt(0)" ::: "memory");
        }
    }
    __syncthreads();
}

__device__ __forceinline__ void xcd_barrier(unsigned* bar, volatile LAS unsigned* st) {
  asm volatile("" : "+s"(bar));
  XcdBarrier b; b.bar = bar; b.x = xb_xcc_id(); b.st = st;
  xcd_barrier_(b);
}

__device__ __forceinline__ void run_phase(const Params& p, int ph, char* smem) {
  char* ws = p.ws;
  const float* mod0 = (const float*)(ws + OFF_MOD);
  const float* mod1 = mod0 + 2 * 6144;
  float* hctx = (float*)(ws + OFF_HCTX);
  const u16* abuf = (const u16*)(ws + OFF_ABUF);
  if (ph == 0) { if (PHEN(0)) phase_prep(p, smem); return; }
  if (ph == 1 || ph == 7 || ph == 10 || ph == 17) {
    if (!(PHEN(1))) return;
    const int l = ph >= 10;
    const bool mix = (ph == 1 || ph == 10);
    phase_normmod(p, ph == 1 ? p.in[2] : hctx, ph == 1 ? p.in[0] : p.out, (mix ? p.in[4] : p.in[5]) + l * 1024,
                  l ? mod1 : mod0, mix ? 0 : 3072, mix ? 1024 : 4096, ph == 10, ph == 1 ? hctx : nullptr);
    return;
  }
  if (ph == 2) { if (!PHEN(2)) return; GemmArgs g{}; g.A = abuf; g.lda = 1024; g.W = (const u16*)(ws + OFF_WGIN); g.K = 1024; g.ntn = 13; g.rt0 = 0; g.nrt = 65; gemm_phase<EPI_GLA_IN, 1024, 1024>(p, g, smem); return; }
  if (ph == 3) { if (PHEN(3)) phase_gla_a(p, smem); return; }
  if (ph == 4) { if (PHEN(4)) phase_gla_scan(p); return; }
  if (ph == 5) { if (PHEN(5)) phase_gla_b(p, smem); return; }
  if (ph == 6 || ph == 9 || ph == 16 || ph == 19) {
    if (!PHEN(6)) return;
    GemmArgs g{};
    const int l = ph >= 16;
    const bool ffn = (ph == 9 || ph == 19);
    g.A = ffn ? (const u16*)(ws + OFF_HID) : abuf; g.lda = ffn ? HID : 1024; g.K = ffn ? HID : 1024; g.ntn = 4; g.rt0 = l; g.nrt = 65 - l;
    g.W = ffn ? (const u16*)(ws + OFF_W2) + (size_t)l * 1024 * 2816 : (const u16*)(ws + (l ? OFF_WLOUT : OFF_WGOUT));
    g.src_ctx = (ph == 6) ? p.in[2] : hctx; g.src_lat = (ph == 6) ? p.in[0] : p.out; g.dst_ctx = hctx; g.dst_lat = p.out;
    g.gate_lat = (l ? mod1 : mod0) + (ffn ? 5120 : 2048); g.perm = (ph == 16);
    if (l == 0) { g.rt0 = 1; g.nrt = 64; g.ctxsplit = 1; }
    if (ffn) gemm_phase<EPI_RESID, HID, HID>(p, g, smem); else gemm_phase<EPI_RESID, 1024, 1024>(p, g, smem);
    return;
  }
  if (ph == 8 || ph == 18) {
    if (!PHEN(8)) return;
    GemmArgs g{}; g.A = abuf; g.lda = 1024; g.W = (const u16*)(ws + OFF_W13) + (size_t)(ph == 18) * 5632 * 1024; g.K = 1024; g.ntn = 22; g.rt0 = (ph == 18); g.nrt = 65 - (ph == 18);
    gemm_phase<EPI_SWIGLU, 1024, 1024>(p, g, smem); return;
  }
  if (ph == 11) { if (!PHEN(11)) return; GemmArgs g{}; g.A = abuf; g.lda = 1024; g.W = (const u16*)(ws + OFF_WLIN); g.K = 1024; g.ntn = 8; g.rt0 = 0; g.nrt = 65; gemm_phase<EPI_LRU_IN, 1024, 1024>(p, g, smem); return; }
  if (ph == 12) { if (PHEN(12)) phase_conv(p); return; }
  if (ph == 13) { if (!PHEN(13)) return; GemmArgs g{}; g.A = abuf; g.lda = 1024; g.W = (const u16*)(ws + OFF_WGATE); g.K = 256; g.ntn = 16; g.rt0 = 0; g.nrt = 65; gemm_phase<EPI_GATES, 256, 1024>(p, g, smem); return; }
  if (ph == 14) { if (PHEN(14)) phase_scan_a(p); return; }
  if (ph == 15) { if (PHEN(15)) phase_scan_c(p, smem); return; }
  if (ph == 20) { if (PHEN(20)) phase_final(p); return; }
}

typedef const Params __attribute__((address_space(4)))* CParamsP;
#define XBAR() xcd_barrier((unsigned*)(kp()->ws + OFF_BAR), (volatile LAS unsigned*)&xb_words)
__device__ __forceinline__ const Params* kp() {
  CParamsP pp = (CParamsP)__builtin_amdgcn_kernarg_segment_ptr();
  asm volatile("" : "+s"(pp));
  return (const Params*)pp;
}
#if REPN > 1
#define RUNPH(n) do { run_phase(*kp(), n, smem); if ((REPMASK >> (n)) & 1u) { XBAR(); run_phase(*kp(), n, smem); } \
    if ((n) == 3 && RSEQ_AFTER == 3) { XBAR(); run_phase(*kp(), 2, smem); XBAR(); run_phase(*kp(), 3, smem); } \
    if ((n) == 4 && RSEQ_AFTER == 4) { XBAR(); run_phase(*kp(), 2, smem); XBAR(); run_phase(*kp(), 3, smem); XBAR(); run_phase(*kp(), 4, smem); } \
    if ((n) + 1 < NPHASE) XBAR(); } while (0)
#else
#define RUNPH(n) do { run_phase(*kp(), n, smem); \
    if ((n) == 3 && RSEQ_AFTER == 3) { XBAR(); run_phase(*kp(), 2, smem); XBAR(); run_phase(*kp(), 3, smem); } \
    if ((n) == 4 && RSEQ_AFTER == 4) { XBAR(); run_phase(*kp(), 2, smem); XBAR(); run_phase(*kp(), 3, smem); XBAR(); run_phase(*kp(), 4, smem); } \
    if ((n) + 1 < NPHASE) XBAR(); } while (0)
#endif

__global__ void __launch_bounds__(512, 2) k_all(Params p, int ph0, int ph1) {
  extern __shared__ __attribute__((aligned(16))) char smem[];
  __shared__ uint4 xb_words;
  if (threadIdx.x == 0) xb_words = make_uint4(0u, 0u, 0u, 0u);
  __syncthreads();
  (void)xcd_barrier_post((unsigned*)(kp()->ws + OFF_BAR), (volatile LAS unsigned*)&xb_words);
  if (ph1 < 0) cg::this_grid().sync();
#if XSYNC > 0
  for (int i = 0; i < XSYNC; ++i) XBAR();
#endif
  RUNPH(0); RUNPH(1); RUNPH(2); RUNPH(3); RUNPH(4); RUNPH(5); RUNPH(6); RUNPH(7); RUNPH(8); RUNPH(9); RUNPH(10);
  RUNPH(11); RUNPH(12); RUNPH(13); RUNPH(14); RUNPH(15); RUNPH(16); RUNPH(17); RUNPH(18); RUNPH(19); RUNPH(20);
}

extern "C" void kernel_launch(void* const* d_in, const int* in_sizes, int n_in, void* d_out, int out_size,
                              void* d_ws, size_t ws_size, hipStream_t stream) {
  static int grid_blocks = 0;
  if (!grid_blocks) {
    hipFuncSetAttribute((const void*)k_all, hipFuncAttributeMaxDynamicSharedMemorySize, DYN_LDS);
    int dev = 0, cus = 0, per_cu = 0;
    hipGetDevice(&dev);
    hipDeviceGetAttribute(&cus, hipDeviceAttributeMultiprocessorCount, dev);
    hipOccupancyMaxActiveBlocksPerMultiprocessor(&per_cu, k_all, NTHR, DYN_LDS);
    if (per_cu < 1) per_cu = 1;
    if (per_cu > 1) per_cu = 1;
    grid_blocks = cus * per_cu;
  }
  Params p{};
  for (int i = 0; i < 27; ++i) p.in[i] = (const float*)d_in[i];
  p.out = (float*)d_out;
  p.ws = (char*)d_ws;
  int ph0 = 0, ph1 = NPHASE;
  hipMemsetAsync((char*)d_ws + OFF_BAR, 0, 16384, stream);
  void* args[] = {&p, &ph0, &ph1};
  hipError_t e = hipLaunchCooperativeKernel((const void*)k_all, dim3(grid_blocks), dim3(NTHR), args, DYN_LDS, stream);
  if (e != hipSuccess) fprintf(stderr, "cooperative launch failed: %s (grid %d)\n", hipGetErrorString(e), grid_blocks);
}
```

```cpp
#include <hip/hip_runtime.h>
#include <hip/hip_cooperative_groups.h>
#include <stdint.h>
#include <stdio.h>
namespace cg = cooperative_groups;

#ifndef MEGA
#define MEGA 1
#endif
#ifndef XSYNC
#define XSYNC 0
#endif
#ifndef REPN
#define REPN 1
#endif
#ifndef REPMASK
#define REPMASK 0u
#endif
#ifndef RSEQ_AFTER
#define RSEQ_AFTER -1
#endif
#ifndef RSEQ_FROM
#define RSEQ_FROM 0
#endif
#ifndef ONLY
#define ONLY -1
#endif
#ifndef PMASK
#define PMASK 0xFFFFFFFFu
#endif
#define PHEN(n) (((ONLY) < 0 || (ONLY) == (n)) && ((PMASK >> (n)) & 1u))

typedef unsigned short u16;
typedef __attribute__((ext_vector_type(8))) short bf16x8;
typedef __attribute__((ext_vector_type(4))) float f32x4;

constexpr int MR = 16640;
constexpr int HID = 2816;
constexpr int LDT = 72;
constexpr int LDK = 136;
constexpr int DYN_LDS = 131072;
constexpr int NTHR = 512;
constexpr int NPHASE = 21;

constexpr size_t OFF_WGIN = 0;
constexpr size_t OFF_WGOUT = OFF_WGIN + (size_t)3328 * 1024 * 2;
constexpr size_t OFF_WLIN = OFF_WGOUT + (size_t)1024 * 1024 * 2;
constexpr size_t OFF_WGATE = OFF_WLIN + (size_t)2048 * 1024 * 2;
constexpr size_t OFF_WLOUT = OFF_WGATE + (size_t)2 * 2048 * 256 * 2;
constexpr size_t OFF_W13 = OFF_WLOUT + (size_t)1024 * 1024 * 2;
constexpr size_t OFF_W2 = OFF_W13 + (size_t)2 * 5632 * 1024 * 2;
constexpr size_t OFF_MOD = OFF_W2 + (size_t)2 * 1024 * 2816 * 2;
constexpr size_t OFF_BAR = OFF_MOD + (size_t)2 * 2 * 6144 * 4;
constexpr size_t OFF_HCTX = OFF_BAR + 16384;
constexpr size_t OFF_ABUF = OFF_HCTX + (size_t)256 * 1024 * 4;
constexpr size_t OFF_REG = OFF_ABUF + (size_t)MR * 1024 * 2;
constexpr size_t SZ_QK = (size_t)MR * 512 * 2;
constexpr size_t OFF_Q0 = OFF_REG;
constexpr size_t OFF_K0 = OFF_Q0 + SZ_QK;
constexpr size_t OFF_Q1 = OFF_K0 + SZ_QK;
constexpr size_t OFF_K1 = OFF_Q1 + SZ_QK;
constexpr size_t OFF_VT = OFF_K1 + SZ_QK;
constexpr size_t OFF_G = OFF_VT + (size_t)1024 * MR * 2;
constexpr size_t OFF_R = OFF_G + (size_t)MR * 1024 * 2;
constexpr size_t OFF_UT = OFF_R + (size_t)MR * 32 * 4;
constexpr size_t OFF_DEC = OFF_UT + (size_t)2 * 65 * 4 * 32768 * 2;
constexpr size_t END_GLA = OFF_DEC + (size_t)2 * 65 * 4 * 128 * 4;
constexpr size_t OFF_HID = OFF_REG;
constexpr size_t OFF_Y = OFF_REG;
constexpr size_t OFF_LA = OFF_Y + (size_t)MR * 1024 * 2;
constexpr size_t OFF_BB = OFF_LA + (size_t)2 * MR * 1024 * 2;
constexpr size_t OFF_U = OFF_LA;
constexpr size_t OFF_AGG = OFF_BB + (size_t)2 * MR * 1024 * 2;
constexpr int NSEG = 136;
constexpr size_t END_LRU = OFF_AGG + (size_t)2 * 2 * NSEG * 1024 * 4;
static_assert(END_GLA <= 268435456ull, "ws");
static_assert(END_LRU <= 268435456ull, "ws");
static_assert(OFF_HID + (size_t)MR * HID * 2 <= 268435456ull, "ws");

struct Params {
  const float* in[27];
  float* out;
  char* ws;
};

typedef __attribute__((ext_vector_type(2))) __bf16 bf16v2;
typedef __attribute__((ext_vector_type(2))) float f32v2;
__device__ __forceinline__ u16 f2bf(float f) { return __builtin_bit_cast(u16, (__bf16)f); }
__device__ __forceinline__ float bf2f(u16 h) { return __uint_as_float(((unsigned)h) << 16); }
__device__ __forceinline__ unsigned pack2(float a, float b) {
  f32v2 v = {a, b};
  return __builtin_bit_cast(unsigned, __builtin_convertvector(v, bf16v2));
}
__device__ __forceinline__ float sigmoid_f(float x) { return __frcp_rn(1.f + __expf(-x)); }
__device__ __forceinline__ float silu_f(float x) { return x * sigmoid_f(x); }
__device__ __forceinline__ float softplus_f(float x) { return fmaxf(x, 0.f) + log1pf(__expf(-fabsf(x))); }
__device__ __forceinline__ float gelu_tanh(float x) {
  float u = 0.7978845608028654f * (x + 0.044715f * x * x * x);
  float th = 1.f - 2.f * __frcp_rn(1.f + __expf(2.f * u));
  return 0.5f * x * (1.f + th);
}
__device__ __forceinline__ f32x4 mfma16(bf16x8 a, bf16x8 b, f32x4 c) {
  return __builtin_amdgcn_mfma_f32_16x16x32_bf16(a, b, c, 0, 0, 0);
}
__device__ __forceinline__ bf16x8 lds_frag(const u16* s, int off) {
  return *reinterpret_cast<const bf16x8*>(s + off);
}

__device__ __forceinline__ int opaque_tid() { int t = threadIdx.x; asm volatile("" : "+v"(t)); return t; }

struct TJob {
  const float* src; int src_ld; int K; int N; u16* dst; int dst_ld; int map; int which; int nbase; float scale; int scale_n;
};
__device__ __forceinline__ TJob get_job(const Params& p, int j) {
  TJob t; t.map = 0; t.which = 0; t.nbase = 0; t.scale = 1.f; t.scale_n = 0;
  char* ws = p.ws;
  if (j == 0) { t.src = p.in[8]; t.src_ld = 3072; t.K = 1024; t.N = 3072; t.dst = (u16*)(ws + OFF_WGIN); t.dst_ld = 1024; t.scale = 0.08838834764831845f; t.scale_n = 512; }
  else if (j <= 2) { int d = j - 1; t.src = p.in[9] + d * 1024 * 16; t.src_ld = 16; t.K = 1024; t.N = 16; t.dst = (u16*)(ws + OFF_WGIN); t.dst_ld = 1024; t.nbase = 3072 + d * 16; }
  else if (j == 3) { t.src = p.in[13]; t.src_ld = 1024; t.K = 1024; t.N = 1024; t.dst = (u16*)(ws + OFF_WGOUT); t.dst_ld = 1024; }
  else if (j == 4) { t.src = p.in[14]; t.src_ld = 2048; t.K = 1024; t.N = 2048; t.dst = (u16*)(ws + OFF_WLIN); t.dst_ld = 1024; }
  else if (j <= 20) { int q = j - 5; int d = q >> 3, g = (q >> 1) & 3, gate = q & 1;
    t.src = (gate ? p.in[19] : p.in[17]) + (size_t)(d * 4 + g) * 65536; t.src_ld = 256; t.K = 256; t.N = 256;
    t.dst = (u16*)(ws + OFF_WGATE) + (size_t)d * 2048 * 256; t.dst_ld = 256; t.map = 1; t.which = gate; t.nbase = g * 512; }
  else if (j == 21) { t.src = p.in[22]; t.src_ld = 1024; t.K = 1024; t.N = 1024; t.dst = (u16*)(ws + OFF_WLOUT); t.dst_ld = 1024; }
  else if (j <= 25) { int q = j - 22; int l = q >> 1, which = q & 1;
    t.src = (which ? p.in[24] : p.in[23]) + (size_t)l * 1024 * 2816; t.src_ld = 2816; t.K = 1024; t.N = 2816;
    t.dst = (u16*)(ws + OFF_W13) + (size_t)l * 5632 * 1024; t.dst_ld = 1024; t.map = 1; t.which = which; }
  else { int l = j - 26; t.src = p.in[25] + (size_t)l * 2816 * 1024; t.src_ld = 1024; t.K = 2816; t.N = 1024;
    t.dst = (u16*)(ws + OFF_W2) + (size_t)l * 1024 * 2816; t.dst_ld = 2816; }
  return t;
}
__device__ __forceinline__ void prep_tile(const TJob& t, int tl, bool act, float* tile, int tid) {
  const int nkt = t.K >> 6;
  const int tlc = act ? tl : 0;
  const int k0 = (tlc % nkt) * 64, n0 = (tlc / nkt) * 64;
  {
    const int nn = tid & 63, kb = tid >> 6;
    const bool ok = act && (n0 + nn) < t.N;
    const float sc = ((n0 + nn) < t.scale_n) ? t.scale : 1.f;
#pragma unroll
    for (int i = 0; i < 16; ++i) {
      int kk = kb + i * 4;
      float v = ok ? t.src[(size_t)(k0 + kk) * t.src_ld + n0 + nn] * sc : 0.f;
      tile[kk * 65 + nn] = v;
    }
  }
  __syncthreads();
  {
    const int kk = tid & 63, nb = tid >> 6;
#pragma unroll
    for (int i = 0; i < 16; ++i) {
      int nn = nb + i * 4; int n = n0 + nn;
      if (act && n < t.N) {
        int drow = t.map ? (t.nbase + (n >> 4) * 32 + t.which * 16 + (n & 15)) : (t.nbase + n);
        t.dst[(size_t)drow * t.dst_ld + k0 + kk] = f2bf(tile[kk * 65 + nn]);
      }
    }
  }
  __syncthreads();
}
__device__ __forceinline__ bool job_is_early(int j) { return j <= 3 || j == 22 || j == 23; }
constexpr int NDEFER_TILES = 3840;

constexpr int NJOBS = 28;
constexpr int NMODITEMS = 192;

__device__ __forceinline__ void phase_prep(const Params& p, char* smem) {
  const int tid0 = opaque_tid(); const int tid = tid0 & 255;
  const int vhalf = __builtin_amdgcn_readfirstlane(tid0 >> 8);
  smem += vhalf * 65536;
  float* tile = (float*)smem;
  const int vb = blockIdx.x * 2 + vhalf, nvb = gridDim.x * 2;
  if (vb < NMODITEMS) {
    const int mi = vb; const int l = mi / 96, ng = mi % 96;
    const int cq = tid & 15, kq = tid >> 4;
    const float* wm = p.in[6] + (size_t)l * 1024 * 6144 + ng * 64 + cq * 4;
    float al[4] = {0, 0, 0, 0}, ac[4] = {0, 0, 0, 0};
#pragma unroll 8
    for (int k = kq; k < 1024; k += 16) {
      float4 w = *reinterpret_cast<const float4*>(wm + (size_t)k * 6144);
      float sl = silu_f(p.in[1][k]), sc = silu_f(p.in[3][k]);
      al[0] += sl * w.x; al[1] += sl * w.y; al[2] += sl * w.z; al[3] += sl * w.w;
      ac[0] += sc * w.x; ac[1] += sc * w.y; ac[2] += sc * w.z; ac[3] += sc * w.w;
    }
    float* red = (float*)smem;
#pragma unroll
    for (int e = 0; e < 4; ++e) { red[(0 * 16 + kq) * 64 + cq * 4 + e] = al[e]; red[(1 * 16 + kq) * 64 + cq * 4 + e] = ac[e]; }
  }
  __syncthreads();
  if (vb < NMODITEMS && tid < 128) {
    const int mi = vb; const int l = mi / 96, ng = mi % 96;
    float* red = (float*)smem;
    int sidx = tid >> 6, col = tid & 63; float sum = 0.f;
#pragma unroll
    for (int q = 0; q < 16; ++q) sum += red[(sidx * 16 + q) * 64 + col];
    int n = ng * 64 + col;
    float* mod = (float*)(p.ws + OFF_MOD);
    mod[(l * 2 + sidx) * 6144 + n] = sum + p.in[7][l * 6144 + n];
  }
  if (vb == nvb - 1) {
    u16* w = (u16*)(p.ws + OFF_WGIN) + (size_t)3104 * 1024;
    for (int i = tid; i < 224 * 1024 / 8; i += 256) reinterpret_cast<uint4*>(w)[i] = make_uint4(0, 0, 0, 0);
  }
  __syncthreads();
  int offset = 0;
  for (int j = 0; j < NJOBS; ++j) {
    if (!job_is_early(j)) continue;
    const TJob t = get_job(p, j);
    const int nkt = t.K >> 6;
    const int ntile = nkt * ((t.N + 63) >> 6);
    const int first0 = (((blockIdx.x * 2) - offset) % nvb + nvb) % nvb;
    const int first1 = (((blockIdx.x * 2 + 1) - offset) % nvb + nvb) % nvb;
    const int fmin = min(first0, first1);
    const int first = vhalf ? first1 : first0;
    for (int base = 0; fmin + base < ntile; base += nvb) {
      const int tl = first + base;
      prep_tile(t, tl, tl < ntile, tile, tid);
    }
    offset = (offset + ntile) % nvb;
  }
}

__device__ __forceinline__ void phase_normmod(const Params& p, const float* src_ctx, const float* src_lat, const float* gvec,
                              const float* modl, int sh_off, int sc_off, int perm, float* hctx_init) {
  const int tid_ = opaque_tid(); const int lane = tid_ & 63, wave = tid_ >> 6;
  u16* abuf = (u16*)(p.ws + OFF_ABUF);
  const int gw = blockIdx.x * 8 + wave, nw = gridDim.x * 8;
  for (int dr = gw; dr < 256; dr += nw) {
    const float* src = src_ctx + (size_t)dr * 1024; const float* mods = modl + 6144;
    float4 v[4]; float ss = 0.f;
#pragma unroll
    for (int i = 0; i < 4; ++i) { v[i] = *reinterpret_cast<const float4*>(src + i * 256 + lane * 4); ss += v[i].x * v[i].x + v[i].y * v[i].y + v[i].z * v[i].z + v[i].w * v[i].w; }
    if (hctx_init) {
#pragma unroll
      for (int i = 0; i < 4; ++i) *reinterpret_cast<float4*>(hctx_init + (size_t)dr * 1024 + i * 256 + lane * 4) = v[i];
    }
#pragma unroll
    for (int o = 32; o >= 1; o >>= 1) ss += __shfl_xor(ss, o);
    const float rstd = rsqrtf(ss * (1.f / 1024.f) + 1e-6f);
#pragma unroll
    for (int i = 0; i < 4; ++i) {
      int col = i * 256 + lane * 4;
      float4 g = *reinterpret_cast<const float4*>(gvec + col);
      float4 sc = *reinterpret_cast<const float4*>(mods + sc_off + col);
      float4 sh = *reinterpret_cast<const float4*>(mods + sh_off + col);
      uint2 o2;
      o2.x = pack2(v[i].x * rstd * g.x * (1.f + sc.x) + sh.x, v[i].y * rstd * g.y * (1.f + sc.y) + sh.y);
      o2.y = pack2(v[i].z * rstd * g.z * (1.f + sc.z) + sh.z, v[i].w * rstd * g.w * (1.f + sc.w) + sh.w);
      *reinterpret_cast<uint2*>(abuf + (size_t)dr * 1024 + col) = o2;
    }
  }
  float4 gs[4], shv[4];
#pragma unroll
  for (int i = 0; i < 4; ++i) {
    int col = i * 256 + lane * 4;
    float4 g = *reinterpret_cast<const float4*>(gvec + col);
    float4 sc = *reinterpret_cast<const float4*>(modl + sc_off + col);
    shv[i] = *reinterpret_cast<const float4*>(modl + sh_off + col);
    gs[i].x = g.x * (1.f + sc.x); gs[i].y = g.y * (1.f + sc.y); gs[i].z = g.z * (1.f + sc.z); gs[i].w = g.w * (1.f + sc.w);
  }
  for (int t0 = gw; t0 < 16384; t0 += 2 * nw) {
    const int t1 = t0 + nw;
    const bool has1 = t1 < 16384;
    const int t1c = has1 ? t1 : t0;
    const int lr0 = perm ? ((t0 & 255) * 64 + (t0 >> 8)) : t0;
    const int lr1 = perm ? ((t1c & 255) * 64 + (t1c >> 8)) : t1c;
    const float* s0 = src_lat + (size_t)lr0 * 1024; const float* s1 = src_lat + (size_t)lr1 * 1024;
    float4 v0[4], v1[4]; float ss0 = 0.f, ss1 = 0.f;
#pragma unroll
    for (int i = 0; i < 4; ++i) { v0[i] = *reinterpret_cast<const float4*>(s0 + i * 256 + lane * 4); v1[i] = *reinterpret_cast<const float4*>(s1 + i * 256 + lane * 4); }
#pragma unroll
    for (int i = 0; i < 4; ++i) {
      ss0 += v0[i].x * v0[i].x + v0[i].y * v0[i].y + v0[i].z * v0[i].z + v0[i].w * v0[i].w;
      ss1 += v1[i].x * v1[i].x + v1[i].y * v1[i].y + v1[i].z * v1[i].z + v1[i].w * v1[i].w;
    }
#pragma unroll
    for (int o = 32; o >= 1; o >>= 1) { ss0 += __shfl_xor(ss0, o); ss1 += __shfl_xor(ss1, o); }
    const float r0 = rsqrtf(ss0 * (1.f / 1024.f) + 1e-6f), r1 = rsqrtf(ss1 * (1.f / 1024.f) + 1e-6f);
#pragma unroll
    for (int i = 0; i < 4; ++i) {
      int col = i * 256 + lane * 4;
      uint2 o2;
      o2.x = pack2(v0[i].x * r0 * gs[i].x + shv[i].x, v0[i].y * r0 * gs[i].y + shv[i].y);
      o2.y = pack2(v0[i].z * r0 * gs[i].z + shv[i].z, v0[i].w * r0 * gs[i].w + shv[i].w);
      *reinterpret_cast<uint2*>(abuf + (size_t)(256 + t0) * 1024 + col) = o2;
      if (has1) {
        uint2 o3;
        o3.x = pack2(v1[i].x * r1 * gs[i].x + shv[i].x, v1[i].y * r1 * gs[i].y + shv[i].y);
        o3.y = pack2(v1[i].z * r1 * gs[i].z + shv[i].z, v1[i].w * r1 * gs[i].w + shv[i].w);
        *reinterpret_cast<uint2*>(abuf + (size_t)(256 + t1) * 1024 + col) = o3;
      }
    }
  }
}

enum { EPI_GLA_IN = 0, EPI_RESID = 1, EPI_SWIGLU = 2, EPI_LRU_IN = 3, EPI_GATES = 4 };
struct GemmArgs {
  const u16* A; int lda; const u16* W; int K; int ntn; int rt0; int nrt;
  const float* src_ctx; const float* src_lat; float* dst_ctx; float* dst_lat; const float* gate_lat; int perm; int ctxsplit;
};
constexpr int G_BK = 64, G_HALF = 128, G_HT = G_HALF * G_BK;
__device__ __forceinline__ int lds_byte(int r, int c) {
  int st = (r >> 4) * 2 + (c >> 5), rr = r & 15, cc = c & 31, ob = rr * 64 + cc * 2;
  return st * 1024 + (ob ^ (((ob >> 9) & 1) << 5));
}
__device__ __forceinline__ void stage_rc(int b, int& R, int& C) {
  int st = b / 1024, sb = b % 1024, swz = sb ^ (((sb >> 9) & 1) << 5);
  R = (st >> 1) * 16 + swz / 64; C = (st & 1) * 32 + (swz % 64) / 2;
}

template <int WH> __device__ __forceinline__ int stage_tix(int r, int chunk) {
  if (WH == 64) return 16384 + r * 64 + ((chunk ^ (r & 7)) << 3);
  return (r < 128 ? 16384 : 49152) + (r & 127) * 128 + ((chunk ^ (r & 15)) << 3);
}

template <int EPI, int KC, int LDAC>
__device__ __forceinline__ void gemm_phase(const Params& p, const GemmArgs g, char* smem) {
  u16* shm = (u16*)smem;
#define SA(b, h) (shm + ((b) * 2 + (h)) * G_HT)
#define SB(b, h) (shm + (4 + (b) * 2 + (h)) * G_HT)
#define STAGE(P, BASE, LD, br, kt) do { const char* _gb = (const char*)((BASE) + (long)(br) * (LD) + (long)(kt) * G_BK); \
    for (int _i = 0; _i < 2; ++_i) { int _b = tid * 16 + _i * 8192; \
      __builtin_amdgcn_global_load_lds((const unsigned*)(_gb + ((LD) == lda ? offA[_i] : offB[_i])), \
        (__attribute__((address_space(3))) unsigned*)((char*)(P) + _b), 16, 0, 0); } } while (0)
#define LDA(dst, b, h) for (int m = 0; m < 4; ++m) for (int k = 0; k < 2; ++k) \
    dst[m][k] = *reinterpret_cast<const bf16x8*>((char*)SA(b, h) + lds_byte(wr * 64 + m * 16 + fr, k * 32 + fq * 8))
#define LDB(dst, b, h) for (int n = 0; n < 2; ++n) for (int k = 0; k < 2; ++k) \
    dst[n][k] = *reinterpret_cast<const bf16x8*>((char*)SB(b, h) + lds_byte(wc * 32 + n * 16 + fr, k * 32 + fq * 8))
#define MMA(ai, bj, At, Bt) do { __builtin_amdgcn_s_setprio(1); \
    for (int m = 0; m < 4; ++m) for (int n = 0; n < 2; ++n) for (int k = 0; k < 2; ++k) \
      acc[ai][bj][m][n] = __builtin_amdgcn_mfma_f32_16x16x32_bf16(At[m][k], Bt[n][k], acc[ai][bj][m][n], 0, 0, 0); \
    __builtin_amdgcn_s_setprio(0); } while (0)
#define WAIT_V(n) asm volatile("s_waitcnt vmcnt(" #n ")" ::: "memory")
#define WAIT_L(n) asm volatile("s_waitcnt lgkmcnt(" #n ")" ::: "memory")
#define BAR __builtin_amdgcn_s_barrier()
#define SCHED __builtin_amdgcn_sched_barrier(0)
  const int ntn = g.ntn, nrt = g.nrt, ntiles = nrt * ntn;
  constexpr int K = KC, lda = LDAC, ntfull = K / G_BK;
  const bool csplit = (EPI == EPI_RESID) && g.ctxsplit;
  const int nunits = ntiles + (csplit ? ntn * (K / 256) : 0);
  for (int t = blockIdx.x; t < nunits; t += gridDim.x) {
    const int tid = opaque_tid();
    const int wid = tid >> 6, lane = tid & 63, wr = wid >> 2, wc = wid & 3, fr = lane & 15, fq = lane >> 4;
    int brow, bcol, koff = 0, nt = ntfull;
    bool part = false;
    if (t < ntiles) {
      int x = t & 7, j = t >> 3, q = ntiles >> 3, r = ntiles & 7;
      int v = (x < r ? x * (q + 1) : r * (q + 1) + (x - r) * q) + j;
      int grp = v / (8 * ntn); int first = grp * 8; int gsz = min(8, nrt - first);
      int vo = v - grp * 8 * ntn;
      brow = (g.rt0 + first + vo % gsz) * 256; bcol = (vo / gsz) * 256;
    } else {
      const int u = t - ntiles;
      brow = 0; bcol = (u % ntn) * 256; koff = (u / ntn) * 256; nt = 4; part = true;
    }
    int acoff = 0;
    if (EPI == EPI_GATES) acoff = ((bcol & 2047) >> 9) * 256;
    const u16* A = g.A + acoff + koff;
    const u16* Bt = g.W + koff;
    f32x4 acc[2][2][4][2];
    bf16x8 At[4][2], B0[2][2], B1[2][2];
    unsigned offA[2], offB[2];
#pragma unroll
    for (int _i = 0; _i < 2; ++_i) { int _r, _c; stage_rc(tid * 16 + _i * 8192, _r, _c); offA[_i] = (unsigned)(_r * lda + _c) * 2u; offB[_i] = (unsigned)(_r * K + _c) * 2u; }
    constexpr bool PF = (EPI == EPI_SWIGLU || EPI == EPI_LRU_IN || EPI == EPI_GLA_IN);
    const bool prefetched = PF && (t != (int)blockIdx.x);
    if (!prefetched) {
      STAGE(SB(0, 0), Bt, K, bcol, 0); STAGE(SA(0, 0), A, lda, brow, 0);
      STAGE(SB(0, 1), Bt, K, bcol + G_HALF, 0); STAGE(SA(0, 1), A, lda, brow + G_HALF, 0);
    }
    if (wr == 1) BAR;
    if (prefetched) { WAIT_V(0); } else { WAIT_V(4); }
    BAR;
    STAGE(SB(1, 0), Bt, K, bcol, 1); STAGE(SA(1, 0), A, lda, brow, 1); STAGE(SB(1, 1), Bt, K, bcol + G_HALF, 1);
    WAIT_V(6); BAR;
#pragma unroll
    for (int a = 0; a < 2; ++a)
#pragma unroll
      for (int b = 0; b < 2; ++b)
#pragma unroll
        for (int m = 0; m < 4; ++m)
#pragma unroll
          for (int n = 0; n < 2; ++n) acc[a][b][m][n] = f32x4{0.f, 0.f, 0.f, 0.f};
    for (int t2 = 0; t2 < nt - 2; t2 += 2) {
      LDB(B0, 0, 0); SCHED; LDA(At, 0, 0); STAGE(SA(1, 1), A, lda, brow + G_HALF, t2 + 1);
      WAIT_L(8); BAR; WAIT_L(0); MMA(0, 0, At, B0); BAR; SCHED;
      LDB(B1, 0, 1); STAGE(SB(0, 0), Bt, K, bcol, t2 + 2);
      BAR; WAIT_L(0); MMA(0, 1, At, B1); BAR;
      LDA(At, 0, 1); STAGE(SA(0, 0), A, lda, brow, t2 + 2);
      BAR; WAIT_L(0); MMA(1, 0, At, B0); BAR; SCHED;
      STAGE(SB(0, 1), Bt, K, bcol + G_HALF, t2 + 2);
      WAIT_V(6); BAR; MMA(1, 1, At, B1); BAR;
      LDB(B0, 1, 0); SCHED; LDA(At, 1, 0); STAGE(SA(0, 1), A, lda, brow + G_HALF, t2 + 2);
      WAIT_L(8); BAR; WAIT_L(0); MMA(0, 0, At, B0); BAR; SCHED;
      LDB(B1, 1, 1); STAGE(SB(1, 0), Bt, K, bcol, t2 + 3);
      BAR; WAIT_L(0); MMA(0, 1, At, B1); BAR;
      LDA(At, 1, 1); STAGE(SA(1, 0), A, lda, brow, t2 + 3);
      BAR; WAIT_L(0); MMA(1, 0, At, B0); BAR; SCHED;
      STAGE(SB(1, 1), Bt, K, bcol + G_HALF, t2 + 3);
      WAIT_V(6); BAR; MMA(1, 1, At, B1); BAR;
    }
    { LDB(B0, 0, 0); LDA(At, 0, 0); STAGE(SA(1, 1), A, lda, brow + G_HALF, nt - 1);
      BAR; WAIT_L(0); MMA(0, 0, At, B0); BAR;
      LDB(B1, 0, 1); BAR; WAIT_L(0); MMA(0, 1, At, B1); BAR;
      LDA(At, 0, 1); WAIT_V(4); BAR; WAIT_L(0); MMA(1, 0, At, B0); MMA(1, 1, At, B1); BAR; }
    { LDB(B0, 1, 0); LDA(At, 1, 0); WAIT_V(2); BAR; WAIT_L(0); MMA(0, 0, At, B0); BAR;
      LDB(B1, 1, 1); WAIT_V(0); BAR; WAIT_L(0); MMA(0, 1, At, B1); BAR;
      LDA(At, 1, 1); BAR; WAIT_L(0); MMA(1, 0, At, B0); MMA(1, 1, At, B1); BAR; }
    if (wr == 0) BAR;
    if (PF) {
      const int tn_ = t + gridDim.x;
      if (tn_ < ntiles) {
        int x = tn_ & 7, j = tn_ >> 3, q = ntiles >> 3, r = ntiles & 7;
        int v = (x < r ? x * (q + 1) : r * (q + 1) + (x - r) * q) + j;
        int grp = v / (8 * ntn); int first = grp * 8; int gsz = min(8, nrt - first);
        int vo = v - grp * 8 * ntn;
        const int nbrow = (g.rt0 + first + vo % gsz) * 256, nbcol = (vo / gsz) * 256;
        STAGE(SB(0, 0), Bt, K, nbcol, 0); STAGE(SA(0, 0), A, lda, nbrow, 0);
        STAGE(SB(0, 1), Bt, K, nbcol + G_HALF, 0); STAGE(SA(0, 1), A, lda, nbrow + G_HALF, 0);
      }
    }
    char* ws = p.ws;
    const int tide = opaque_tid();
    const int wre = tide >> 8, wce = (tide >> 6) & 3, fre = tide & 15, fqe = (tide & 63) >> 4;
    const bool direct = (EPI == EPI_RESID) || (EPI == EPI_GLA_IN && ((bcol >= 1024 && bcol < 2048) || bcol >= 3072));
    if (direct) {
#pragma unroll
      for (int ai = 0; ai < 2; ++ai)
#pragma unroll
        for (int bj = 0; bj < 2; ++bj) {
          const int rbase = brow + ai * 128 + wre * 64 + fqe * 4;
          const int cbase = bcol + bj * 128 + wce * 32 + fre;
          if (EPI == EPI_GLA_IN) {
            if (bcol < 2048) {
              u16* vt = (u16*)(ws + OFF_VT);
#pragma unroll
              for (int m = 0; m < 4; ++m)
#pragma unroll
                for (int n = 0; n < 2; ++n) {
                  uint2 o2; o2.x = pack2(acc[ai][bj][m][n][0], acc[ai][bj][m][n][1]); o2.y = pack2(acc[ai][bj][m][n][2], acc[ai][bj][m][n][3]);
                  *reinterpret_cast<uint2*>(vt + (size_t)(cbase + n * 16 - 1024) * MR + rbase + m * 16) = o2;
                }
            } else {
              float* rb2 = (float*)(ws + OFF_R);
#pragma unroll
              for (int m = 0; m < 4; ++m)
#pragma unroll
                for (int n = 0; n < 2; ++n) {
                  int cl = cbase + n * 16 - 3072;
                  if (cl < 32) {
#pragma unroll
                    for (int j = 0; j < 4; ++j) rb2[(size_t)(rbase + m * 16 + j) * 32 + cl] = acc[ai][bj][m][n][j];
                  }
                }
            }
          } else if (EPI == EPI_RESID) {
            const bool isctx = brow < 256;
            const float* gate = isctx ? (g.gate_lat + 6144) : g.gate_lat;
            float gv[2];
#pragma unroll
            for (int n = 0; n < 2; ++n) gv[n] = gate[cbase + n * 16];
#pragma unroll
            for (int m = 0; m < 4; ++m)
#pragma unroll
              for (int j = 0; j < 4; ++j) {
                int dr = rbase + m * 16 + j;
                const float* sp; float* dp;
                if (isctx) { sp = g.src_ctx + (size_t)dr * 1024; dp = g.dst_ctx + (size_t)dr * 1024; }
                else { int tt = dr - 256; int lr = g.perm ? ((tt & 255) * 64 + (tt >> 8)) : tt; sp = g.src_lat + (size_t)lr * 1024; dp = g.dst_lat + (size_t)lr * 1024; }
#pragma unroll
                for (int n = 0; n < 2; ++n) {
                  int c = cbase + n * 16;
                  if (part) atomicAdd(dp + c, gv[n] * acc[ai][bj][m][n][j]);
                  else dp[c] = sp[c] + gv[n] * acc[ai][bj][m][n][j];
                }
              }
          }
        }
    } else {
      constexpr int WH = (EPI == EPI_SWIGLU || EPI == EPI_GATES) ? 64 : 128;
      constexpr bool SWZ = (EPI == EPI_SWIGLU || EPI == EPI_LRU_IN || EPI == EPI_GLA_IN);
      constexpr int LDW = WH + 8;
      constexpr int CPR = WH / 8;
      u16* T0 = (u16*)smem;
      u16* S0 = (u16*)smem;
      u16* T1 = T0 + 256 * LDW;
      u16* TU = T1 + 256 * LDW;
#pragma unroll
      for (int bj = 0; bj < 2; ++bj) {
        int chb = 0, gd = 0;
        float ba = 0.f, bx = 0.f, spl = 0.f;
        if (EPI == EPI_GATES) {
          gd = bcol >> 11;
          chb = ((bcol & 2047) >> 9) * 256 + ((bcol & 511) >> 5) * 16 + bj * 64;
          const u16* uc = (const u16*)(ws + OFF_ABUF);
#pragma unroll
          for (int i = 0; i < 4; ++i) {
            int id = tide + 512 * i, r = id >> 3, c = id & 7;
            *reinterpret_cast<uint4*>(TU + r * LDW + c * 8) = *reinterpret_cast<const uint4*>(uc + (size_t)(brow + r) * 1024 + chb + c * 8);
          }
          const int ch = chb + wce * 16 + fre;
          ba = p.in[18][gd * 1024 + ch]; bx = p.in[20][gd * 1024 + ch];
          spl = softplus_f(-p.in[21][gd * 1024 + ch]);
          __syncthreads();
        }
#pragma unroll
        for (int ai = 0; ai < 2; ++ai)
#pragma unroll
          for (int m = 0; m < 4; ++m)
#pragma unroll
            for (int j = 0; j < 4; ++j) {
              const int rowl = ai * 128 + wre * 64 + m * 16 + fqe * 4 + j;
              if (EPI == EPI_SWIGLU) {
                float a1 = acc[ai][bj][m][0][j], a3 = acc[ai][bj][m][1][j];
                S0[bj * 32768 + stage_tix<64>(rowl, wce * 2 + (fre >> 3)) + (fre & 7)] = f2bf(silu_f(a1) * a3);
              } else if (EPI == EPI_GATES) {
                float r = sigmoid_f(acc[ai][bj][m][0][j] + ba);
                float ig = sigmoid_f(acc[ai][bj][m][1][j] + bx);
                float la = -8.f * r * spl;
                float ucv = bf2f(TU[rowl * LDW + wce * 16 + fre]);
                float bbv = __fsqrt_rn(fmaxf(1.f - __expf(2.f * la), 0.f)) * ig * ucv;
                T0[rowl * LDW + wce * 16 + fre] = f2bf(la);
                T1[rowl * LDW + wce * 16 + fre] = f2bf(bbv);
              } else {
#pragma unroll
                for (int n = 0; n < 2; ++n) {
                  float v = acc[ai][bj][m][n][j];
                  if (EPI == EPI_LRU_IN && bcol < 1024) v = gelu_tanh(v);
                  S0[stage_tix<128>(rowl, wce * 4 + n * 2 + (fre >> 3)) + (fre & 7)] = f2bf(v);
                }
              }
            }
        __syncthreads();
        {
          u16* d0; u16* d1 = nullptr; size_t ld; int col0;
          if (EPI == EPI_SWIGLU) { d0 = (u16*)(ws + OFF_HID); ld = HID; col0 = (bcol >> 5) * 16 + bj * 64; }
          else if (EPI == EPI_GATES) { d0 = (u16*)(ws + OFF_LA) + (size_t)gd * MR * 1024; d1 = (u16*)(ws + OFF_BB) + (size_t)gd * MR * 1024; ld = 1024; col0 = chb; }
          else if (EPI == EPI_LRU_IN) { d0 = (u16*)(ws + (bcol < 1024 ? OFF_Y : OFF_U)); ld = 1024; col0 = (bcol & 1023) + bj * 128; }
          else {
            if (bcol < 1024) { d0 = (u16*)(ws + (bcol < 512 ? OFF_Q0 : OFF_K0)); d1 = (u16*)(ws + (bcol < 512 ? OFF_Q1 : OFF_K1)); ld = 512; col0 = (bcol & 511) + bj * 128; }
            else { d0 = (u16*)(ws + OFF_G); ld = 1024; col0 = bcol - 2048 + bj * 128; }
          }
#pragma unroll
          for (int i = 0; i < 256 * CPR / 512; ++i) {
            int id = tide + 512 * i, r = id / CPR, c = id % CPR;
            uint4 v = *reinterpret_cast<const uint4*>(SWZ ? (S0 + ((EPI == EPI_SWIGLU) ? bj * 32768 : 0) + stage_tix<WH>(r, c)) : (T0 + r * LDW + c * 8));
            size_t o = (size_t)(brow + r) * ld + col0 + c * 8;
            *reinterpret_cast<uint4*>(d0 + o) = v;
            if (EPI == EPI_GATES) { uint4 v1 = *reinterpret_cast<const uint4*>(T1 + r * LDW + c * 8); *reinterpret_cast<uint4*>(d1 + o) = v1; }
            else if (EPI == EPI_GLA_IN) { if (d1) *reinterpret_cast<uint4*>(d1 + o) = v; }
          }
        }
        if (!(EPI == EPI_SWIGLU && bj == 0)) __syncthreads();
      }
    }
    if (direct) __syncthreads();
  }
#undef SA
#undef SB
#undef STAGE
#undef LDA
#undef LDB
#undef MMA
#undef WAIT_V
#undef WAIT_L
#undef BAR
#undef SCHED
}

__device__ __forceinline__ void phase_gla_a(const Params& p, char* smem) {
  const int tid0 = opaque_tid(); const int tid = tid0 & 255, lane = tid & 63, wave = tid >> 6, l15 = lane & 15, l4 = lane >> 4;
  const int vhalf = __builtin_amdgcn_readfirstlane(tid0 >> 8);
  smem += vhalf * 65536;
  u16* sKT = (u16*)smem;
  u16* sV = sKT + 128 * LDT;
  float* sDec = (float*)(sV + 128 * LDT);
  float* sR = sDec + 256;
  char* ws = p.ws;
  const u16* VT = (const u16*)(ws + OFF_VT);
  const float* R = (const float*)(ws + OFF_R);
  for (int base = 0; base < 260; base += 2 * gridDim.x) {
    const int it0 = base + blockIdx.x + gridDim.x * vhalf;
    const bool active = it0 < 260;
    if (!active) {
      const int q = it0 - 260;
      float* tile = (float*)smem;
      for (int i = 0; i < 17; ++i) {
        const int dt = q * 17 + i;
        const bool act = (q >= 0) && dt < NDEFER_TILES && base == 0;
        int rem = act ? dt : 0; int j = 4; TJob t = get_job(p, 4);
        for (;;) {
          if (!job_is_early(j)) { int nt_ = (t.K >> 6) * ((t.N + 63) >> 6); if (rem < nt_) break; rem -= nt_; }
          ++j; if (j >= NJOBS) { j = 4; rem = 0; t = get_job(p, 4); break; }
          t = get_job(p, j);
        }
        prep_tile(t, rem, act, tile, tid);
      }
      __syncthreads();
      continue;
    }
    const int it = it0;
    const int pc = it >> 2, dir = (it >> 1) & 1, hp = it & 1;
    const int lc = dir ? (pc == 0 ? 0 : 65 - pc) : pc;
    u16* Q = (u16*)(ws + (dir ? OFF_Q1 : OFF_Q0));
    u16* Kb = (u16*)(ws + (dir ? OFF_K1 : OFF_K0));
    {
      const int h2 = tid >> 7, ch = tid & 127, head = hp * 2 + h2;
      {
        const float4* rsrc = reinterpret_cast<const float4*>(R + (size_t)(pc * 256 + tid) * 32 + dir * 16);
        float4* rdst = reinterpret_cast<float4*>(sR + tid * 16);
        rdst[0] = rsrc[0]; rdst[1] = rsrc[1]; rdst[2] = rsrc[2]; rdst[3] = rsrc[3];
      }
      float w2[16];
#pragma unroll
      for (int m = 0; m < 16; ++m) w2[m] = p.in[10][(dir * 16 + m) * 512 + head * 128 + ch];
      const float gbv = p.in[11][dir * 512 + head * 128 + ch];
      __syncthreads();
      float B = 0.f;
#define GLA_QK_LOAD(t8_, qd, kd) { _Pragma("unroll") for (int s = 0; s < 8; ++s) { \
          int lp = (t8_) * 8 + s; int ip = dir ? 255 - lp : lp; \
          size_t o = (size_t)(pc * 256 + ip) * 512 + head * 128 + ch; qd[s] = Q[o]; kd[s] = Kb[o]; } }
#define GLA_QK_COMP(t8_, qd, kd) { _Pragma("unroll") for (int s = 0; s < 8; ++s) { \
          int lp = (t8_) * 8 + s; int ip = dir ? 255 - lp : lp; \
          const float4* rr = reinterpret_cast<const float4*>(sR + ip * 16); \
          float z = gbv; \
          _Pragma("unroll") for (int m4 = 0; m4 < 4; ++m4) { float4 r4 = rr[m4]; \
            z += r4.x * w2[m4 * 4] + r4.y * w2[m4 * 4 + 1] + r4.z * w2[m4 * 4 + 2] + r4.w * w2[m4 * 4 + 3]; } \
          B -= __logf(1.f + __expf(-z)) * (1.f / 16.f); \
          if (active) { size_t o = (size_t)(pc * 256 + ip) * 512 + head * 128 + ch; const float eB = __expf(B); \
            Q[o] = f2bf(bf2f(qd[s]) * eB); Kb[o] = f2bf(bf2f(kd[s]) * __frcp_rn(eB)); } } }
      {
        u16 qa[8], ka[8], qb[8], kb[8];
        GLA_QK_LOAD(0, qa, ka)
        for (int t16 = 0; t16 < 16; ++t16) {
          GLA_QK_LOAD(2 * t16 + 1, qb, kb)
          GLA_QK_COMP(2 * t16, qa, ka)
          { const int tn = t16 < 15 ? 2 * t16 + 2 : 31; GLA_QK_LOAD(tn, qa, ka) }
          GLA_QK_COMP(2 * t16 + 1, qb, kb)
        }
      }
      const float dec = __expf(B);
      sDec[tid] = dec;
      if (active) ((float*)(ws + OFF_DEC))[((dir * 65 + lc) * 4 + head) * 128 + ch] = dec;
    }
    __threadfence_block();
    __syncthreads();
    {
      f32x4 acc[2][8];
#pragma unroll
      for (int m = 0; m < 2; ++m)
#pragma unroll
        for (int n = 0; n < 8; ++n) acc[m][n] = f32x4{0.f, 0.f, 0.f, 0.f};
#define GLA_LK(i, dst) { dst = *reinterpret_cast<const uint4*>(kp_ + (i) * 16 * 512); }
#define GLA_LV(i, dst) { dst = *reinterpret_cast<const uint4*>(vp_ + (size_t)((i) * 32) * MR); }
#define GLA_GLOAD(st_) do { \
        const int h2_ = (st_) >> 3, dvh_ = ((st_) >> 2) & 1, tb_ = (st_) & 3, head_ = hp * 2 + h2_; \
        const int rowb_ = pc * 256 + tb_ * 64; \
        const u16* kp_ = Kb + (size_t)rowb_ * 512 + head_ * 128 + (unsigned)((tid >> 4) * 512 + (tid & 15) * 8); \
        const u16* vp_ = VT + (size_t)(head_ * 256 + dvh_ * 128) * MR + rowb_ + (unsigned)((tid >> 3) * MR + (tid & 7) * 8); \
        GLA_LK(0, rk0) GLA_LK(1, rk1) GLA_LK(2, rk2) GLA_LK(3, rk3) GLA_LV(0, rv0) GLA_LV(1, rv1) GLA_LV(2, rv2) GLA_LV(3, rv3) \
      } while (0)
#define GLA_SK(i, src) { int id = tid + 256 * (i), tok = id >> 4, c = id & 15; const uint4 kq = src; \
          const int cs_ = (((tok >> 3) ^ (c & 7)) << 3) + (tok & 7);     \
          sKT[(c * 8 + 0) * LDT + cs_] = (u16)(kq.x & 0xffff); sKT[(c * 8 + 1) * LDT + cs_] = (u16)(kq.x >> 16); \
          sKT[(c * 8 + 2) * LDT + cs_] = (u16)(kq.y & 0xffff); sKT[(c * 8 + 3) * LDT + cs_] = (u16)(kq.y >> 16); \
          sKT[(c * 8 + 4) * LDT + cs_] = (u16)(kq.z & 0xffff); sKT[(c * 8 + 5) * LDT + cs_] = (u16)(kq.z >> 16); \
          sKT[(c * 8 + 6) * LDT + cs_] = (u16)(kq.w & 0xffff); sKT[(c * 8 + 7) * LDT + cs_] = (u16)(kq.w >> 16); }
#define GLA_SV(i, src) { int id = tid + 256 * (i), r = id >> 3, c = id & 7; *reinterpret_cast<uint4*>(sV + r * LDT + c * 8) = src; }
      uint4 rk0, rk1, rk2, rk3, rv0, rv1, rv2, rv3;
      GLA_GLOAD(0);
      for (int st = 0; st < 16; ++st) {
        GLA_SK(0, rk0) GLA_SK(1, rk1) GLA_SK(2, rk2) GLA_SK(3, rk3)
        GLA_SV(0, rv0) GLA_SV(1, rv1) GLA_SV(2, rv2) GLA_SV(3, rv3)
        __syncthreads();
        GLA_GLOAD(st < 15 ? st + 1 : 15);
#pragma unroll
        for (int kk = 0; kk < 2; ++kk) {
          bf16x8 af[2];
#pragma unroll
          for (int m = 0; m < 2; ++m) af[m] = lds_frag(sV, (wave * 32 + m * 16 + l15) * LDT + kk * 32 + l4 * 8);
#pragma unroll
          for (int n = 0; n < 8; ++n) {
            bf16x8 b = lds_frag(sKT, (n * 16 + l15) * LDT + (((kk * 4 + l4) ^ ((n * 2 + (l15 >> 3)) & 7)) << 3));
#pragma unroll
            for (int m = 0; m < 2; ++m) acc[m][n] = mfma16(af[m], b, acc[m][n]);
          }
        }
        __syncthreads();
        if ((st & 3) == 3) {
          const int h2 = st >> 3, dvh = (st >> 2) & 1, head = hp * 2 + h2;
          u16* UT = (u16*)(ws + OFF_UT) + (size_t)((dir * 65 + lc) * 4 + head) * 32768;
#pragma unroll
          for (int n = 0; n < 8; ++n) {
            int dk = n * 16 + l15; float dd = sDec[h2 * 128 + dk];
#pragma unroll
            for (int m = 0; m < 2; ++m) {
              if (active) {
#pragma unroll
                for (int j = 0; j < 4; ++j) {
                  int dv = dvh * 128 + wave * 32 + m * 16 + l4 * 4 + j;
                  UT[dv * 128 + dk] = f2bf(acc[m][n][j] * dd);
                }
              }
              acc[m][n] = f32x4{0.f, 0.f, 0.f, 0.f};
            }
          }
        }
      }
    }
    __syncthreads();
  }
}

__device__ __forceinline__ void phase_gla_scan(const Params& p) {
  char* ws = p.ws;
  const float* DEC = (const float*)(ws + OFF_DEC);
  for (int idx = blockIdx.x * NTHR + opaque_tid(); idx < 131072; idx += gridDim.x * NTHR) {
    int e = idx * 2; int dir = e >> 17; int head = (e >> 15) & 3; int w = e & 32767; int dk = w & 127;
    float s0 = 0.f, s1 = 0.f;
    for (int lb = 0; lb < 65; lb += 13) {
      unsigned u[13]; float d0[13], d1[13];
#pragma unroll
      for (int i = 0; i < 13; ++i) {
        int lc = lb + i;
        u[i] = *reinterpret_cast<const unsigned*>((u16*)(ws + OFF_UT) + (size_t)((dir * 65 + lc) * 4 + head) * 32768 + w);
        float2 dd = *reinterpret_cast<const float2*>(DEC + ((dir * 65 + lc) * 4 + head) * 128 + dk);
        d0[i] = dd.x; d1[i] = dd.y;
      }
#pragma unroll
      for (int i = 0; i < 13; ++i) {
        int lc = lb + i;
        *reinterpret_cast<unsigned*>((u16*)(ws + OFF_UT) + (size_t)((dir * 65 + lc) * 4 + head) * 32768 + w) = pack2(s0, s1);
        s0 = d0[i] * s0 + bf2f((u16)(u[i] & 0xffff));
        s1 = d1[i] * s1 + bf2f((u16)(u[i] >> 16));
      }
    }
  }
}

__device__ __forceinline__ void phase_gla_b(const Params& p, char* smem) {
  const int vhalf = __builtin_amdgcn_readfirstlane(opaque_tid() >> 8);
  smem += vhalf * 65536;
  u16* sK = (u16*)smem;
  u16* sB = sK + 64 * LDK;
  u16* sP = sB + 256 * LDT;
  char* ws = p.ws;
  const u16* VT = (const u16*)(ws + OFF_VT);
  for (int it = blockIdx.x * 2 + vhalf; it < 1040; it += gridDim.x * 2) {
    const int pc = it >> 4, head = (it >> 2) & 3, ib = it & 3;
    const int tid = opaque_tid() & 255, lane = tid & 63, wave = tid >> 6, l15 = lane & 15, l4 = lane >> 4;
    f32x4 o[16];
#pragma unroll
    for (int n = 0; n < 16; ++n) o[n] = f32x4{0.f, 0.f, 0.f, 0.f};
    const int n0 = 3 + ib;
    uint4 vb0, vb1, vb2, vb3, vb4, vb5, vb6, vb7, kb0, kb1, kb2, kb3;
    bf16x8 qf[4];
#define GLB_LV(i, dst) { dst = *reinterpret_cast<const uint4*>(bp + (size_t)((i) * 32) * bstride); }
#define GLB_LK(i, dst) { dst = *reinterpret_cast<const uint4*>(kp + (i) * 16 * 512); }
#define GLB_PREFETCH(s_) do { \
      const int d_ = (s_) >= n0, ls_ = (s_) - d_ * n0; \
      const int lc_ = d_ ? (pc == 0 ? 0 : 65 - pc) : pc; \
      const u16* bsrc; int bstride; \
      if (ls_ < 2) { bsrc = (const u16*)(ws + OFF_UT) + (size_t)((d_ * 65 + lc_) * 4 + head) * 32768 + ls_ * 64; bstride = 128; } \
      else { const int jb_ = d_ ? ib + ls_ - 2 : ls_ - 2; bsrc = VT + (size_t)(head * 256) * MR + pc * 256 + jb_ * 64; bstride = MR; \
        const u16* ksrc = (const u16*)(ws + (d_ ? OFF_K1 : OFF_K0)) + (size_t)(pc * 256 + jb_ * 64) * 512 + head * 128; \
        const u16* kp = ksrc + (unsigned)((tid >> 4) * 512 + (tid & 15) * 8); \
        GLB_LK(0, kb0) GLB_LK(1, kb1) GLB_LK(2, kb2) GLB_LK(3, kb3) } \
      const u16* bp = bsrc + (unsigned)((tid >> 3) * bstride + (tid & 7) * 8); \
      GLB_LV(0, vb0) GLB_LV(1, vb1) GLB_LV(2, vb2) GLB_LV(3, vb3) GLB_LV(4, vb4) GLB_LV(5, vb5) GLB_LV(6, vb6) GLB_LV(7, vb7) \
    } while (0)
#define GLB_SV(i, src) { int id = tid + 256 * (i), r = id >> 3, c = id & 7; *reinterpret_cast<uint4*>(sB + r * LDT + c * 8) = src; }
#define GLB_SK(i, src) { int id = tid + 256 * (i), r = id >> 4, c = id & 15; *reinterpret_cast<uint4*>(sK + r * LDK + c * 8) = src; }
#define GLB_LQ(d_) { const u16* qrow = (const u16*)(ws + ((d_) ? OFF_Q1 : OFF_Q0)) + (size_t)(pc * 256 + ib * 64 + wave * 16 + l15) * 512 + head * 128 + l4 * 8; \
      _Pragma("unroll") for (int ks = 0; ks < 4; ++ks) qf[ks] = *reinterpret_cast<const bf16x8*>(qrow + ks * 32); }
    GLB_LQ(0)
    const int sskip = (pc == 0) ? 2 : 0;
    int st = sskip;
    GLB_PREFETCH(st);
    while (st < 9) {
      const int dir = st >= n0, ls = st - dir * n0;
      GLB_SV(0, vb0) GLB_SV(1, vb1) GLB_SV(2, vb2) GLB_SV(3, vb3) GLB_SV(4, vb4) GLB_SV(5, vb5) GLB_SV(6, vb6) GLB_SV(7, vb7)
      if (ls >= 2) { GLB_SK(0, kb0) GLB_SK(1, kb1) GLB_SK(2, kb2) GLB_SK(3, kb3) }
      if (st == n0 + sskip) GLB_LQ(1)
      int snx = st + 1; if (snx == n0) snx += sskip;
      { const int sn = snx < 8 ? snx : 8; GLB_PREFETCH(sn); }
      __syncthreads();
      if (ls < 2) {
#pragma unroll
        for (int kk = 0; kk < 2; ++kk) {
          const bf16x8 a = (ls == 0) ? (kk == 0 ? qf[0] : qf[1]) : (kk == 0 ? qf[2] : qf[3]);
#pragma unroll
          for (int n = 0; n < 16; ++n) {
            bf16x8 b = lds_frag(sB, (n * 16 + l15) * LDT + kk * 32 + l4 * 8);
            o[n] = mfma16(a, b, o[n]);
          }
        }
      } else {
        const int jb = dir ? ib + ls - 2 : ls - 2;
        f32x4 sc[4];
#pragma unroll
        for (int n = 0; n < 4; ++n) sc[n] = f32x4{0.f, 0.f, 0.f, 0.f};
#pragma unroll
        for (int ks = 0; ks < 4; ++ks)
#pragma unroll
          for (int n = 0; n < 4; ++n) {
            bf16x8 b = lds_frag(sK, (n * 16 + l15) * LDK + ks * 32 + l4 * 8);
            sc[n] = mfma16(qf[ks], b, sc[n]);
          }
        const bool diag = (jb == ib);
#pragma unroll
        for (int n = 0; n < 4; ++n)
#pragma unroll
          for (int j = 0; j < 4; ++j) {
            int ii = wave * 16 + l4 * 4 + j, jj = n * 16 + l15;
            float v = sc[n][j];
            if (diag) { bool keep = dir ? (jj >= ii) : (jj <= ii); v = keep ? v : 0.f; }
            sP[ii * LDT + jj] = f2bf(v);
          }
        asm volatile("s_waitcnt lgkmcnt(0)" ::: "memory");
#pragma unroll
        for (int kk = 0; kk < 2; ++kk) {
          bf16x8 a = lds_frag(sP, (wave * 16 + l15) * LDT + kk * 32 + l4 * 8);
#pragma unroll
          for (int n = 0; n < 16; ++n) {
            bf16x8 b = lds_frag(sB, (n * 16 + l15) * LDT + kk * 32 + l4 * 8);
            o[n] = mfma16(a, b, o[n]);
          }
        }
      }
      __syncthreads();
      st = snx;
    }
    const u16* G = (const u16*)(ws + OFF_G);
    u16* og = (u16*)(ws + OFF_ABUF);
    const float* hn = p.in[12];
#pragma unroll
    for (int j = 0; j < 4; ++j) {
      float ss = 0.f;
#pragma unroll
      for (int n = 0; n < 16; ++n) ss += o[n][j] * o[n][j];
      ss += __shfl_xor(ss, 1); ss += __shfl_xor(ss, 2); ss += __shfl_xor(ss, 4); ss += __shfl_xor(ss, 8);
      const float rstd = rsqrtf(ss * (1.f / 256.f) + 1e-6f);
      const size_t row = (size_t)(pc * 256 + ib * 64 + wave * 16 + l4 * 4 + j);
#pragma unroll
      for (int n = 0; n < 16; ++n) {
        int dv = n * 16 + l15;
        float gv = bf2f(G[row * 1024 + head * 256 + dv]);
        og[row * 1024 + head * 256 + dv] = f2bf(o[n][j] * rstd * hn[dv] * silu_f(gv));
      }
    }
  }
}

__device__ __forceinline__ void phase_conv(const Params& p) {
  const u16* U = (const u16*)(p.ws + OFF_U);
  u16* uc = (u16*)(p.ws + OFF_ABUF);
  const float* cw = p.in[15]; const float* cb = p.in[16];
  for (int idx = blockIdx.x * NTHR + opaque_tid(); idx < MR * 128; idx += gridDim.x * NTHR) {
    const int row = idx >> 7, c = idx & 127, ch0 = c * 8;
    const int lo = row < 256 ? 0 : 256, hi = row < 256 ? 255 : MR - 1;
    float a[8];
#pragma unroll
    for (int e = 0; e < 8; ++e) a[e] = cb[ch0 + e];
#pragma unroll
    for (int j = 0; j < 4; ++j) {
      int rr = row + j - 2;
      if (rr >= lo && rr <= hi) {
        uint4 v = *reinterpret_cast<const uint4*>(U + (size_t)rr * 1024 + ch0);
        unsigned w[4] = {v.x, v.y, v.z, v.w};
#pragma unroll
        for (int e = 0; e < 4; ++e) {
          a[2 * e] += cw[j * 1024 + ch0 + 2 * e] * bf2f((u16)(w[e] & 0xffff));
          a[2 * e + 1] += cw[j * 1024 + ch0 + 2 * e + 1] * bf2f((u16)(w[e] >> 16));
        }
      }
    }
    uint4 o; o.x = pack2(a[0], a[1]); o.y = pack2(a[2], a[3]); o.z = pack2(a[4], a[5]); o.w = pack2(a[6], a[7]);
    *reinterpret_cast<uint4*>(uc + (size_t)row * 1024 + ch0) = o;
  }
}

__device__ __forceinline__ void seg_geom(int it, int& seg, int& chg, int& row0, int& nrow) {
  if (it < 512) { seg = 8 + (it >> 2); chg = it & 3; row0 = 256 + (seg - 8) * 128; nrow = 128; }
  else { int u = it - 512; seg = u >> 2; chg = u & 3; row0 = seg * 32; nrow = 32; }
}
__device__ __forceinline__ int seg_lidx(int dir, int seg) { return dir ? (seg < 8 ? 7 - seg : 143 - seg) : seg; }

__device__ __forceinline__ void phase_scan_a(const Params& p) {
  const int tid0 = opaque_tid(); const int tid = tid0 & 255;
  const int vhalf = __builtin_amdgcn_readfirstlane(tid0 >> 8);
  char* ws = p.ws;
  float* AGG = (float*)(ws + OFF_AGG);
  for (int it = blockIdx.x * 2 + vhalf; it < 544; it += gridDim.x * 2) {
    int seg, chg, row0, nrow; seg_geom(it, seg, chg, row0, nrow);
    const int dir = tid >> 7, cp = tid & 127;
    const int ch = chg * 256 + cp * 2;
    const u16* LA = (const u16*)(ws + OFF_LA) + (size_t)dir * MR * 1024 + ch;
    const u16* BB = (const u16*)(ws + OFF_BB) + (size_t)dir * MR * 1024 + ch;
    float P0 = 0.f, P1 = 0.f, h0 = 0.f, h1 = 0.f;
    for (int ib = 0; ib < nrow; ib += 16) {
      unsigned la[16], bb[16];
#pragma unroll
      for (int i = 0; i < 16; ++i) {
        int ii = ib + i; int row = row0 + (dir ? nrow - 1 - ii : ii);
        la[i] = *reinterpret_cast<const unsigned*>(LA + (size_t)row * 1024);
        bb[i] = *reinterpret_cast<const unsigned*>(BB + (size_t)row * 1024);
      }
#pragma unroll
      for (int i = 0; i < 16; ++i) {
        float l0 = bf2f((u16)(la[i] & 0xffff)), l1 = bf2f((u16)(la[i] >> 16));
        P0 += l0; P1 += l1;
        h0 = __expf(l0) * h0 + bf2f((u16)(bb[i] & 0xffff));
        h1 = __expf(l1) * h1 + bf2f((u16)(bb[i] >> 16));
      }
    }
    const int lidx = seg_lidx(dir, seg);
    float* ap = AGG + (size_t)(dir * 2 + 0) * NSEG * 1024 + lidx * 1024 + ch;
    float* ah = AGG + (size_t)(dir * 2 + 1) * NSEG * 1024 + lidx * 1024 + ch;
    ap[0] = P0; ap[1] = P1; ah[0] = h0; ah[1] = h1;
  }
}

__device__ __forceinline__ float seg_carry(const float* ap, const float* ah, int lidx) {
  float h = 0.f;
  for (int lb = 0; lb < lidx; lb += 16) {
    float pa[16], ha[16];
#pragma unroll
    for (int i = 0; i < 16; ++i) { int l = min(lb + i, lidx - 1); pa[i] = ap[l * 1024]; ha[i] = ah[l * 1024]; }
#pragma unroll
    for (int i = 0; i < 16; ++i) { if (lb + i < lidx) h = __expf(pa[i]) * h + ha[i]; }
  }
  return h;
}

__device__ __forceinline__ void phase_scan_c(const Params& p, char* smem) {
  const int tid0 = opaque_tid(); const int tid = tid0 & 255;
  const int vhalf = __builtin_amdgcn_readfirstlane(tid0 >> 8);
  char* ws = p.ws;
  u16* sHF = (u16*)(smem + vhalf * 65536);
  const float* AGG = (const float*)(ws + OFF_AGG);
  const u16* Y = (const u16*)(ws + OFF_Y);
  u16* outA = (u16*)(ws + OFF_ABUF);
  for (int it = blockIdx.x * 2 + vhalf; it < 544; it += gridDim.x * 2) {
    int seg, chg, row0, nrow; seg_geom(it, seg, chg, row0, nrow);
    const int ch = chg * 256 + tid;
    {
      float h = seg_carry(AGG + (size_t)0 * NSEG * 1024 + ch, AGG + (size_t)1 * NSEG * 1024 + ch, seg);
      const u16* LA = (const u16*)(ws + OFF_LA) + ch;
      const u16* BB = (const u16*)(ws + OFF_BB) + ch;
      for (int ib = 0; ib < nrow; ib += 16) {
        u16 la[16], bb[16];
#pragma unroll
        for (int i = 0; i < 16; ++i) { size_t row = (size_t)(row0 + ib + i); la[i] = LA[row * 1024]; bb[i] = BB[row * 1024]; }
#pragma unroll
        for (int i = 0; i < 16; ++i) { h = __expf(bf2f(la[i])) * h + bf2f(bb[i]); sHF[(ib + i) * 256 + tid] = f2bf(h); }
      }
    }
    {
      const int lidx = seg_lidx(1, seg);
      float h = seg_carry(AGG + (size_t)2 * NSEG * 1024 + ch, AGG + (size_t)3 * NSEG * 1024 + ch, lidx);
      const u16* LA = (const u16*)(ws + OFF_LA) + (size_t)MR * 1024 + ch;
      const u16* BB = (const u16*)(ws + OFF_BB) + (size_t)MR * 1024 + ch;
      for (int ib = 0; ib < nrow; ib += 16) {
        u16 la[16], bb[16], yv[16];
#pragma unroll
        for (int i = 0; i < 16; ++i) { size_t row = (size_t)(row0 + nrow - 1 - ib - i); la[i] = LA[row * 1024]; bb[i] = BB[row * 1024]; yv[i] = Y[row * 1024 + ch]; }
#pragma unroll
        for (int i = 0; i < 16; ++i) {
          int ii = nrow - 1 - ib - i;
          h = __expf(bf2f(la[i])) * h + bf2f(bb[i]);
          float hf = bf2f(sHF[ii * 256 + tid]);
          outA[(size_t)(row0 + ii) * 1024 + ch] = f2bf((hf + h) * bf2f(yv[i]));
        }
      }
    }
  }
}

__device__ __forceinline__ void phase_final(const Params& p) {
  const int tid_ = opaque_tid(); const int lane = tid_ & 63, wave = tid_ >> 6;
  const float* gvec = p.in[26];
  float4 g[4];
#pragma unroll
  for (int i = 0; i < 4; ++i) g[i] = *reinterpret_cast<const float4*>(gvec + i * 256 + lane * 4);
  const int gw = blockIdx.x * 8 + wave, nw = gridDim.x * 8;
  for (int r0 = gw; r0 < 16384; r0 += 2 * nw) {
    const int r1 = r0 + nw; const bool has1 = r1 < 16384;
    float* s0 = p.out + (size_t)r0 * 1024;
    float* s1 = p.out + (size_t)(has1 ? r1 : r0) * 1024;
    float4 v0[4], v1[4]; float ss0 = 0.f, ss1 = 0.f;
#pragma unroll
    for (int i = 0; i < 4; ++i) { v0[i] = *reinterpret_cast<const float4*>(s0 + i * 256 + lane * 4); v1[i] = *reinterpret_cast<const float4*>(s1 + i * 256 + lane * 4); }
#pragma unroll
    for (int i = 0; i < 4; ++i) {
      ss0 += v0[i].x * v0[i].x + v0[i].y * v0[i].y + v0[i].z * v0[i].z + v0[i].w * v0[i].w;
      ss1 += v1[i].x * v1[i].x + v1[i].y * v1[i].y + v1[i].z * v1[i].z + v1[i].w * v1[i].w;
    }
#pragma unroll
    for (int o = 32; o >= 1; o >>= 1) { ss0 += __shfl_xor(ss0, o); ss1 += __shfl_xor(ss1, o); }
    const float q0 = rsqrtf(ss0 * (1.f / 1024.f) + 1e-6f), q1 = rsqrtf(ss1 * (1.f / 1024.f) + 1e-6f);
#pragma unroll
    for (int i = 0; i < 4; ++i) {
      int col = i * 256 + lane * 4;
      float4 o; o.x = v0[i].x * q0 * g[i].x; o.y = v0[i].y * q0 * g[i].y; o.z = v0[i].z * q0 * g[i].z; o.w = v0[i].w * q0 * g[i].w;
      *reinterpret_cast<float4*>(s0 + col) = o;
      if (has1) {
        float4 o1; o1.x = v1[i].x * q1 * g[i].x; o1.y = v1[i].y * q1 * g[i].y; o1.z = v1[i].z * q1 * g[i].z; o1.w = v1[i].w * q1 * g[i].w;
        *reinterpret_cast<float4*>(s1 + col) = o1;
      }
    }
  }
}

#define XB_TMO      128
#define XB_XCNT(j)  (256  + 64 * (j))
#define XB_XSUB(j)  (1280 + 64 * (j))
#define XB_XGEN(j)  (2304 + 64 * (j))
#define XB_TOP      3328
#define XB_TOPGEN   3392
#define XCD_BAR_WORDS 3456
#define XB_SPIN_CAP (1u << 22)
#define LAS __attribute__((address_space(3)))
__device__ __forceinline__ unsigned xb_ld(unsigned* p)              { return __hip_atomic_load(p, __ATOMIC_RELAXED, __HIP_MEMORY_SCOPE_AGENT); }
__device__ __forceinline__ unsigned xb_add(unsigned* p, unsigned v) { return __hip_atomic_fetch_add(p, v, __ATOMIC_RELAXED, __HIP_MEMORY_SCOPE_AGENT); }
__device__ __forceinline__ unsigned xb_xcc_id() { return (unsigned)__builtin_amdgcn_s_getreg((3 << 11) | 20) & 0xFu; }
#define XB_SPIN(cond, bar) do { unsigned _sp = 0; while (cond) { __builtin_amdgcn_s_sleep(1); \
    if ((++_sp & 255u) == 0u) { if (xb_ld(&(bar)[XB_TMO])) break; if (_sp > XB_SPIN_CAP) { atomicAdd(&(bar)[XB_TMO], 1u); break; } } } } while (0)
struct XcdBarrier { unsigned* bar; unsigned x; volatile LAS unsigned* st; };
__device__ __forceinline__ XcdBarrier xcd_barrier_post(unsigned* bar, volatile LAS unsigned* st) {
    XcdBarrier b; b.bar = bar; b.x = xb_xcc_id(); b.st = st;
    if (threadIdx.x == 0) (void)xb_add(&bar[XB_XCNT(b.x)], 1u);
    return b;
}
__device__ __forceinline__ void xcd_barrier_complete(unsigned* bar, unsigned x, unsigned& nloc, unsigned& nx) {
    const unsigned G = gridDim.x * gridDim.y * gridDim.z;
    unsigned sum, cnt, mine, sp = 0u;
    for (;;) {
        sum = 0u; cnt = 0u; mine = 0u;
#pragma unroll
        for (unsigned j = 0; j < 16; ++j) { const unsigned c = xb_ld(&bar[XB_XCNT(j)]); sum += c; cnt += (c > 0u) ? 1u : 0u; mine = (j == x) ? c : mine; }
        if (sum == G) break;
        __builtin_amdgcn_s_sleep(1);
        if ((++sp & 255u) == 0u) { if (xb_ld(&bar[XB_TMO])) break; if (sp > XB_SPIN_CAP) { atomicAdd(&bar[XB_TMO], 1u); break; } }
    }
    nloc = mine > 0u ? mine : 1u; nx = cnt > 0u ? cnt : 1u;
}
__device__ __forceinline__ void xcd_barrier_(const XcdBarrier& b) {
    asm volatile("s_waitcnt vmcnt(0)" ::: "memory");
    __syncthreads();
    if (threadIdx.x == 0) {
        unsigned* bar = b.bar;
        __builtin_amdgcn_s_waitcnt(0);
        unsigned nloc = b.st[0], nx = b.st[1];
        if (nloc == 0u) { xcd_barrier_complete(bar, b.x, nloc, nx); b.st[0] = nloc; b.st[1] = nx; }
        const unsigned old = xb_add(&bar[XB_XSUB(b.x)], 1u);
        const unsigned gen = old / nloc;
        if (old + 1u == (gen + 1u) * nloc) {
            __builtin_amdgcn_fence(__ATOMIC_RELEASE, "agent");
            asm volatile("s_waitcnt vmcnt(0)" ::: "memory");
            const unsigned og = xb_add(&bar[XB_TOP], 1u);
            const unsigned tg = og / nx;
            if (og + 1u == (tg + 1u) * nx) xb_add(&bar[XB_TOPGEN], 1u);
            else XB_SPIN(xb_ld(&bar[XB_TOPGEN]) == tg, bar);
            __builtin_amdgcn_fence(__ATOMIC_ACQUIRE, "agent");
            xb_add(&bar[XB_XGEN(b.x)], 1u);
            asm volatile("s_waitcnt vmcnt(0)" ::: "memory");
        } else {
            XB_SPIN(xb_ld(&bar[XB_XGEN(b.x)]) == gen, bar);
            __builtin_amdgcn_fence(__ATOMIC_ACQUIRE, "agent");
            asm volatile("s_waitcnt vmcnt(0)" ::: "memory");
        }
    }
    __syncthreads();
}

__device__ __forceinline__ void xcd_barrier(unsigned* bar, volatile LAS unsigned* st) {
  asm volatile("" : "+s"(bar));
  XcdBarrier b; b.bar = bar; b.x = xb_xcc_id(); b.st = st;
  xcd_barrier_(b);
}

__device__ __forceinline__ void run_phase(const Params& p, int ph, char* smem) {
  char* ws = p.ws;
  const float* mod0 = (const float*)(ws + OFF_MOD);
  const float* mod1 = mod0 + 2 * 6144;
  float* hctx = (float*)(ws + OFF_HCTX);
  const u16* abuf = (const u16*)(ws + OFF_ABUF);
  if (ph == 0) { if (PHEN(0)) phase_prep(p, smem); return; }
  if (ph == 1 || ph == 7 || ph == 10 || ph == 17) {
    if (!(PHEN(1))) return;
    const int l = ph >= 10;
    const bool mix = (ph == 1 || ph == 10);
    phase_normmod(p, ph == 1 ? p.in[2] : hctx, ph == 1 ? p.in[0] : p.out, (mix ? p.in[4] : p.in[5]) + l * 1024,
                  l ? mod1 : mod0, mix ? 0 : 3072, mix ? 1024 : 4096, ph == 10, ph == 1 ? hctx : nullptr);
    return;
  }
  if (ph == 2) { if (!PHEN(2)) return; GemmArgs g{}; g.A = abuf; g.lda = 1024; g.W = (const u16*)(ws + OFF_WGIN); g.K = 1024; g.ntn = 13; g.rt0 = 0; g.nrt = 65; gemm_phase<EPI_GLA_IN, 1024, 1024>(p, g, smem); return; }
  if (ph == 3) { if (PHEN(3)) phase_gla_a(p, smem); return; }
  if (ph == 4) { if (PHEN(4)) phase_gla_scan(p); return; }
  if (ph == 5) { if (PHEN(5)) phase_gla_b(p, smem); return; }
  if (ph == 6 || ph == 9 || ph == 16 || ph == 19) {
    if (!PHEN(6)) return;
    GemmArgs g{};
    const int l = ph >= 16;
    const bool ffn = (ph == 9 || ph == 19);
    g.A = ffn ? (const u16*)(ws + OFF_HID) : abuf; g.lda = ffn ? HID : 1024; g.K = ffn ? HID : 1024; g.ntn = 4; g.rt0 = l; g.nrt = 65 - l;
    g.W = ffn ? (const u16*)(ws + OFF_W2) + (size_t)l * 1024 * 2816 : (const u16*)(ws + (l ? OFF_WLOUT : OFF_WGOUT));
    g.src_ctx = (ph == 6) ? p.in[2] : hctx; g.src_lat = (ph == 6) ? p.in[0] : p.out; g.dst_ctx = hctx; g.dst_lat = p.out;
    g.gate_lat = (l ? mod1 : mod0) + (ffn ? 5120 : 2048); g.perm = (ph == 16);
    if (l == 0) { g.rt0 = 1; g.nrt = 64; g.ctxsplit = 1; }
    if (ffn) gemm_phase<EPI_RESID, HID, HID>(p, g, smem); else gemm_phase<EPI_RESID, 1024, 1024>(p, g, smem);
    return;
  }
  if (ph == 8 || ph == 18) {
    if (!PHEN(8)) return;
    GemmArgs g{}; g.A = abuf; g.lda = 1024; g.W = (const u16*)(ws + OFF_W13) + (size_t)(ph == 18) * 5632 * 1024; g.K = 1024; g.ntn = 22; g.rt0 = (ph == 18); g.nrt = 65 - (ph == 18);
    gemm_phase<EPI_SWIGLU, 1024, 1024>(p, g, smem); return;
  }
  if (ph == 11) { if (!PHEN(11)) return; GemmArgs g{}; g.A = abuf; g.lda = 1024; g.W = (const u16*)(ws + OFF_WLIN); g.K = 1024; g.ntn = 8; g.rt0 = 0; g.nrt = 65; gemm_phase<EPI_LRU_IN, 1024, 1024>(p, g, smem); return; }
  if (ph == 12) { if (PHEN(12)) phase_conv(p); return; }
  if (ph == 13) { if (!PHEN(13)) return; GemmArgs g{}; g.A = abuf; g.lda = 1024; g.W = (const u16*)(ws + OFF_WGATE); g.K = 256; g.ntn = 16; g.rt0 = 0; g.nrt = 65; gemm_phase<EPI_GATES, 256, 1024>(p, g, smem); return; }
  if (ph == 14) { if (PHEN(14)) phase_scan_a(p); return; }
  if (ph == 15) { if (PHEN(15)) phase_scan_c(p, smem); return; }
  if (ph == 20) { if (PHEN(20)) phase_final(p); return; }
}

typedef const Params __attribute__((address_space(4)))* CParamsP;
#define XBAR() xcd_barrier((unsigned*)(kp()->ws + OFF_BAR), (volatile LAS unsigned*)&xb_words)
__device__ __forceinline__ const Params* kp() {
  CParamsP pp = (CParamsP)__builtin_amdgcn_kernarg_segment_ptr();
  asm volatile("" : "+s"(pp));
  return (const Params*)pp;
}
#if REPN > 1
#define RUNPH(n) do { run_phase(*kp(), n, smem); if ((REPMASK >> (n)) & 1u) { XBAR(); run_phase(*kp(), n, smem); } \
    if ((n) == 3 && RSEQ_AFTER == 3) { XBAR(); run_phase(*kp(), 2, smem); XBAR(); run_phase(*kp(), 3, smem); } \
    if ((n) == 4 && RSEQ_AFTER == 4) { XBAR(); run_phase(*kp(), 2, smem); XBAR(); run_phase(*kp(), 3, smem); XBAR(); run_phase(*kp(), 4, smem); } \
    if ((n) + 1 < NPHASE) XBAR(); } while (0)
#else
#define RUNPH(n) do { run_phase(*kp(), n, smem); \
    if ((n) == 3 && RSEQ_AFTER == 3) { XBAR(); run_phase(*kp(), 2, smem); XBAR(); run_phase(*kp(), 3, smem); } \
    if ((n) == 4 && RSEQ_AFTER == 4) { XBAR(); run_phase(*kp(), 2, smem); XBAR(); run_phase(*kp(), 3, smem); XBAR(); run_phase(*kp(), 4, smem); } \
    if ((n) + 1 < NPHASE) XBAR(); } while (0)
#endif

__global__ void __launch_bounds__(512, 2) k_all(Params p, int ph0, int ph1) {
  extern __shared__ __attribute__((aligned(16))) char smem[];
  __shared__ uint4 xb_words;
  if (threadIdx.x == 0) xb_words = make_uint4(0u, 0u, 0u, 0u);
  __syncthreads();
  (void)xcd_barrier_post((unsigned*)(kp()->ws + OFF_BAR), (volatile LAS unsigned*)&xb_words);
  if (ph1 < 0) cg::this_grid().sync();
#if XSYNC > 0
  for (int i = 0; i < XSYNC; ++i) XBAR();
#endif
  RUNPH(0); RUNPH(1); RUNPH(2); RUNPH(3); RUNPH(4); RUNPH(5); RUNPH(6); RUNPH(7); RUNPH(8); RUNPH(9); RUNPH(10);
  RUNPH(11); RUNPH(12); RUNPH(13); RUNPH(14); RUNPH(15); RUNPH(16); RUNPH(17); RUNPH(18); RUNPH(19); RUNPH(20);
}

extern "C" void kernel_launch(void* const* d_in, const int* in_sizes, int n_in, void* d_out, int out_size,
                              void* d_ws, size_t ws_size, hipStream_t stream) {
  static int grid_blocks = 0;
  if (!grid_blocks) {
    hipFuncSetAttribute((const void*)k_all, hipFuncAttributeMaxDynamicSharedMemorySize, DYN_LDS);
    int dev = 0, cus = 0, per_cu = 0;
    hipGetDevice(&dev);
    hipDeviceGetAttribute(&cus, hipDeviceAttributeMultiprocessorCount, dev);
    hipOccupancyMaxActiveBlocksPerMultiprocessor(&per_cu, k_all, NTHR, DYN_LDS);
    if (per_cu < 1) per_cu = 1;
    if (per_cu > 1) per_cu = 1;
    grid_blocks = cus * per_cu;
  }
  Params p{};
  for (int i = 0; i < 27; ++i) p.in[i] = (const float*)d_in[i];
  p.out = (float*)d_out;
  p.ws = (char*)d_ws;
  int ph0 = 0, ph1 = NPHASE;
  hipMemsetAsync((char*)d_ws + OFF_BAR, 0, 16384, stream);
  void* args[] = {&p, &ph0, &ph1};
  hipError_t e = hipLaunchCooperativeKernel((const void*)k_all, dim3(grid_blocks), dim3(NTHR), args, DYN_LDS, stream);
  if (e != hipSuccess) fprintf(stderr, "cooperative launch failed: %s (grid %d)\n", hipGetErrorString(e), grid_blocks);
}
```
